# Optimizing an MI355X kernel written in HIP

```python
import math
import jax, jax.numpy as jnp
from jax import lax
import numpy as np

D_MODEL = 1024
BATCH = 2
SEQ = 16384
DEPTH = 2

D_FF = 2816
A_CHUNK = 128
A_GROUPS = 4
A_GROUP_DIM = 128
A_WIDTH = A_GROUPS * A_GROUP_DIM
B_WINDOW = 128
B_Q_HEADS = 8
B_KV_HEADS = 2
B_HEAD_DIM = 64
B_Q_PER_KV = B_Q_HEADS // B_KV_HEADS
B_WIDTH = B_Q_HEADS * B_HEAD_DIM
B_KV_WIDTH = B_KV_HEADS * B_HEAD_DIM
C_CHUNK = 128
C_HEADS = 4
C_QK_DIM = 128
C_V_DIM = 256
C_QK_WIDTH = C_HEADS * C_QK_DIM
C_V_WIDTH = C_HEADS * C_V_DIM
SPLIT_SIZES = (A_WIDTH, A_WIDTH,
               B_WIDTH, B_KV_WIDTH, B_KV_WIDTH,
               C_QK_WIDTH, C_QK_WIDTH, C_V_WIDTH, C_V_WIDTH,
               3 * D_MODEL)
IN_WIDTH = sum(SPLIT_SIZES)
NORM_EPS = 1e-6
GN_EPS = 1e-5

kernel_name = "hybrid_gmlp_swa_retention_macaron"


def rmsnorm(x, g):
    xf = x.astype(jnp.float32)
    y = xf * lax.rsqrt(jnp.mean(xf * xf, axis=-1, keepdims=True) + NORM_EPS)
    return (y * g.astype(jnp.float32)).astype(x.dtype)


def swiglu(h, w_in, w_out):
    a, b = jnp.split(h @ w_in, 2, axis=-1)
    return (jax.nn.silu(a) * b) @ w_out


def gmlp_spatial(z, v_norm, w_s, b_s):
    bsz, t_len, _ = z.shape
    u, v = jnp.split(z, 2, axis=-1)
    v = rmsnorm(v, v_norm)
    vc = v.reshape(bsz, t_len // A_CHUNK, A_CHUNK, A_GROUPS, A_GROUP_DIM)
    causal = jnp.tril(jnp.ones((A_CHUNK, A_CHUNK), dtype=bool))
    w = jnp.where(causal[None], w_s, jnp.zeros_like(w_s))
    s = jnp.einsum('gts,bcsgd->bctgd', w, vc) + b_s.T[None, None, :, :, None]
    return u * s.reshape(bsz, t_len, A_WIDTH)


def swa_attention(q, k, v, sinks):
    bsz, t_len, _ = q.shape
    n = t_len // B_WINDOW
    W = B_WINDOW
    qb = q.reshape(bsz, n, W, B_KV_HEADS, B_Q_PER_KV, B_HEAD_DIM)
    kb = k.reshape(bsz, n, W, B_KV_HEADS, B_HEAD_DIM)
    vb = v.reshape(bsz, n, W, B_KV_HEADS, B_HEAD_DIM)
    pad = ((0, 0), (1, 0), (0, 0), (0, 0), (0, 0))
    kk = jnp.concatenate([jnp.pad(kb, pad)[:, :-1], kb], axis=2)
    vv = jnp.concatenate([jnp.pad(vb, pad)[:, :-1], vb], axis=2)
    scores = jnp.einsum('bnqhgd,bnkhd->bnhgqk', qb, kk).astype(jnp.float32)
    scores = scores * (1.0 / math.sqrt(B_HEAD_DIM))
    qpos = jnp.arange(W)[:, None] + W
    kpos = jnp.arange(2 * W)[None, :]
    dist = (qpos - kpos).astype(jnp.float32)
    valid = (dist >= 0) & (dist < W)
    block_valid = valid[None] & ((jnp.arange(n) > 0)[:, None, None] | (kpos >= W)[None])
    slopes = jnp.exp2(-8.0 / B_Q_HEADS * (jnp.arange(B_Q_HEADS, dtype=jnp.float32) + 1.0))
    alibi = -slopes.reshape(B_KV_HEADS, B_Q_PER_KV)[:, :, None, None] * dist
    scores = jnp.where(block_valid[None, :, None, None], scores + alibi[None, None], -jnp.inf)
    sink = sinks.astype(jnp.float32).reshape(B_KV_HEADS, B_Q_PER_KV)[None, None, :, :, None, None]
    m = jnp.maximum(jnp.max(scores, axis=-1, keepdims=True), sink)
    p = jnp.exp(scores - m)
    probs = p / (jnp.sum(p, axis=-1, keepdims=True) + jnp.exp(sink - m))
    out = jnp.einsum('bnhgqk,bnkhd->bnqhgd', probs.astype(v.dtype), vv)
    return out.reshape(bsz, t_len, B_WIDTH)


def retention(q, k, v, g, gn_gain):
    bsz, t_len, _ = q.shape
    n = t_len // C_CHUNK
    dt = q.dtype
    log_gamma = jnp.log(1.0 - jnp.exp2(-5.0 - jnp.arange(C_HEADS, dtype=jnp.float32)))
    qc = q.reshape(bsz, n, C_CHUNK, C_HEADS, C_QK_DIM)
    kc = k.reshape(bsz, n, C_CHUNK, C_HEADS, C_QK_DIM) * (C_QK_DIM ** -0.5)
    vc = v.reshape(bsz, n, C_CHUNK, C_HEADS, C_V_DIM)
    idx = jnp.arange(C_CHUNK, dtype=jnp.float32)
    dist = idx[:, None] - idx[None, :]
    decay = jnp.where(dist[None] >= 0, jnp.exp(log_gamma[:, None, None] * jnp.maximum(dist, 0.0)[None]), 0.0)
    scores = jnp.einsum('bnthd,bnshd->bnhts', qc, kc) * decay.astype(dt)[None, None]
    inner = jnp.einsum('bnhts,bnshe->bnthe', scores, vc)
    k_w = jnp.exp(log_gamma[None, :] * (C_CHUNK - 1.0 - idx)[:, None]).astype(dt)
    kv = jnp.einsum('bnshd,bnshe->nbhde', kc * k_w[None, None, :, :, None], vc)
    chunk_decay = jnp.exp(log_gamma * C_CHUNK).astype(dt)[None, :, None, None]

    def step(state, kv_i):
        return chunk_decay * state + kv_i, state

    init = jnp.zeros((bsz, C_HEADS, C_QK_DIM, C_V_DIM), dtype=kv.dtype)
    _, s_prev = lax.scan(step, init, kv)
    q_w = jnp.exp(log_gamma[None, :] * (idx + 1.0)[:, None]).astype(dt)
    cross = jnp.einsum('bnthd,nbhde->bnthe', qc * q_w[None, None, :, :, None], s_prev)
    o = (inner + cross).astype(jnp.float32)
    mu = jnp.mean(o, axis=-1, keepdims=True)
    var = jnp.mean(jnp.square(o - mu), axis=-1, keepdims=True)
    o = ((o - mu) * lax.rsqrt(var + GN_EPS)).reshape(bsz, t_len, C_V_WIDTH)
    o = (o * gn_gain.astype(jnp.float32)).astype(dt)
    return o * jax.nn.silu(g)


def hybrid_layer(x, ffn1_norm, ffn1_w_in, ffn1_w_out, mix_norm, w_in, b_gate,
                 gmlp_v_norm, gmlp_w_s, gmlp_b_s, attn_sinks, ret_gn,
                 w_branch_a, w_branch_b, w_branch_c, w_out,
                 ffn2_norm, ffn2_w_in, ffn2_w_out):
    x = x + 0.5 * swiglu(rmsnorm(x, ffn1_norm), ffn1_w_in, ffn1_w_out)
    h = rmsnorm(x, mix_norm)
    p = h @ w_in
    cuts = list(np.cumsum(SPLIT_SIZES)[:-1])
    a_u, a_v, b_q, b_k, b_v, c_q, c_k, c_v, c_g, gate_pre = jnp.split(p, cuts, axis=-1)
    y_a = gmlp_spatial(jax.nn.gelu(jnp.concatenate([a_u, a_v], axis=-1)),
                       gmlp_v_norm, gmlp_w_s, gmlp_b_s) @ w_branch_a
    y_b = swa_attention(b_q, b_k, b_v, attn_sinks) @ w_branch_b
    y_c = retention(c_q, c_k, c_v, c_g, ret_gn) @ w_branch_c
    g_a, g_b, g_c = jnp.split(jax.nn.sigmoid(gate_pre + b_gate), 3, axis=-1)
    merged = g_a * y_a + g_b * y_b + g_c * y_c
    x = x + merged @ w_out
    x = x + 0.5 * swiglu(rmsnorm(x, ffn2_norm), ffn2_w_in, ffn2_w_out)
    return x


def setup_inputs(seed: int = 0) -> dict:
    key = jax.random.key(seed)
    ks = jax.random.split(key, 24)
    L, D, F = DEPTH, D_MODEL, D_FF
    f32 = jnp.float32

    def nrm(k, shape, fan_in):
        return jax.random.normal(k, shape, f32) * (fan_in ** -0.5)

    def gain(k, shape):
        return 1.0 + 0.02 * jax.random.normal(k, shape, f32)

    return {
        "x": jax.random.normal(ks[0], (BATCH, SEQ, D), f32),
        "ffn1_norm": gain(ks[1], (L, D)),
        "ffn1_w_in": nrm(ks[2], (L, D, 2 * F), D),
        "ffn1_w_out": nrm(ks[3], (L, F, D), F),
        "mix_norm": gain(ks[4], (L, D)),
        "w_in": nrm(ks[5], (L, D, IN_WIDTH), D),
        "b_gate": 0.02 * jax.random.normal(ks[6], (L, 3 * D), f32),
        "gmlp_v_norm": gain(ks[7], (L, A_WIDTH)),
        "gmlp_w_s": nrm(ks[8], (L, A_GROUPS, A_CHUNK, A_CHUNK), A_CHUNK),
        "gmlp_b_s": 1.0 + 0.02 * jax.random.normal(ks[9], (L, A_GROUPS, A_CHUNK), f32),
        "attn_sinks": 0.5 * jax.random.normal(ks[10], (L, B_Q_HEADS), f32),
        "ret_gn": gain(ks[11], (L, C_V_WIDTH)),
        "w_branch_a": nrm(ks[12], (L, A_WIDTH, D), A_WIDTH),
        "w_branch_b": nrm(ks[13], (L, B_WIDTH, D), B_WIDTH),
        "w_branch_c": nrm(ks[14], (L, C_V_WIDTH, D), C_V_WIDTH),
        "w_out": nrm(ks[15], (L, D, D), D),
        "ffn2_norm": gain(ks[16], (L, D)),
        "ffn2_w_in": nrm(ks[17], (L, D, 2 * F), D),
        "ffn2_w_out": nrm(ks[18], (L, F, D), F),
        "final_norm": gain(ks[19], (D,)),
    }


def reference(x, ffn1_norm, ffn1_w_in, ffn1_w_out, mix_norm, w_in, b_gate,
              gmlp_v_norm, gmlp_w_s, gmlp_b_s, attn_sinks, ret_gn,
              w_branch_a, w_branch_b, w_branch_c, w_out,
              ffn2_norm, ffn2_w_in, ffn2_w_out, final_norm):
    for l in range(DEPTH):
        x = hybrid_layer(x, ffn1_norm[l], ffn1_w_in[l], ffn1_w_out[l], mix_norm[l],
                         w_in[l], b_gate[l], gmlp_v_norm[l], gmlp_w_s[l], gmlp_b_s[l],
                         attn_sinks[l], ret_gn[l], w_branch_a[l], w_branch_b[l],
                         w_branch_c[l], w_out[l], ffn2_norm[l], ffn2_w_in[l], ffn2_w_out[l])
    return rmsnorm(x, final_norm)
```

```cpp
#include <hip/hip_runtime.h>
#include <hip/hip_cooperative_groups.h>
#include <cstdio>
#include <cstdint>
namespace cg = cooperative_groups;

#ifndef MK_DELAY
#define MK_DELAY 0
#endif
#define MK_WTG 0
#define MK_T10 0
#ifndef MK_GOVL
#define MK_GOVL 0
#endif
#ifndef MK_SCRUB
#define MK_SCRUB 0
#endif
#ifndef MK_WTIN
#define MK_WTIN 0
#endif
#ifndef MK_X3
#define MK_X3 0
#endif
#ifndef MK_X2
#define MK_X2 0
#endif
#ifndef MK_P7
#define MK_P7 6
#endif
#ifndef MK_CGSYNC
#define MK_CGSYNC 0
#endif
#ifndef MK_MULTI
#define MK_MULTI 0
#endif

#define LAS __attribute__((address_space(3)))
typedef unsigned short bf16_t;
typedef short bf16x8 __attribute__((ext_vector_type(8)));
typedef float f32x4 __attribute__((ext_vector_type(4)));
typedef float f32x2 __attribute__((ext_vector_type(2)));
typedef unsigned u32x4 __attribute__((ext_vector_type(4)));
typedef unsigned u32x2 __attribute__((ext_vector_type(2)));

constexpr int M = 32768, D = 1024, F = 2816, NCHUNK = 256, DEPTH = 2;
constexpr int PW = 4864;
constexpr int C_AU = 0, C_AV = 512, C_BQ = 1024, C_BK = 1536, C_BV = 1664, C_CQ = 1792, C_CK = 2304, C_CV = 2816, C_CG = 3840;
constexpr int C_GT = 1792;
constexpr int C_MG = 2816;
constexpr float NORM_EPS = 1e-6f, GN_EPS = 1e-5f, LOG2E = 1.4426950408889634f;
constexpr int MH = 16384;
constexpr int NPH_LAYER = 17, NPHASES = NPH_LAYER * DEPTH + 1;

constexpr size_t MiB = 1u << 20;
constexpr size_t WS_BAR = 0;
constexpr size_t WS_WB = 1 * MiB;
constexpr size_t WS_XB = 57 * MiB;
constexpr size_t WS_P = 121 * MiB;
constexpr size_t WS_KV = 273 * MiB;
constexpr size_t WS_G = 305 * MiB;
constexpr size_t WS_MG = 369 * MiB;
constexpr size_t WS_SSP = 433 * MiB;
constexpr size_t WS_END = 437 * MiB;
constexpr size_t O_W1IN = 0, O_W1OUT = 5767168, O_WIN = 8650752, O_WBA = 16777216, O_WBB = 17301504, O_WBC = 17825792,
                 O_WOUT = 18874368, O_W2IN = 19922944, O_W2OUT = 25690112, O_WS = 28573696, O_WEND = 28639232;
static_assert(O_WEND * 2 <= 56 * MiB, "weights fit");

__device__ __forceinline__ float bflo(unsigned w) { return __uint_as_float(w << 16); }
__device__ __forceinline__ float bfhi(unsigned w) { return __uint_as_float(w & 0xffff0000u); }
__device__ __forceinline__ unsigned f2bf(float f) { unsigned u = __float_as_uint(f); return (u + 0x7fffu + ((u >> 16) & 1u)) >> 16; }
__device__ __forceinline__ unsigned pk2(float lo, float hi) { return f2bf(lo) | (f2bf(hi) << 16); }
__device__ __forceinline__ float fexp2(float x) { return __builtin_amdgcn_exp2f(x); }
__device__ __forceinline__ float frcp(float x) { return __builtin_amdgcn_rcpf(x); }
__device__ __forceinline__ float sigmoid_f(float x) { return frcp(1.0f + fexp2(-x * LOG2E)); }
__device__ __forceinline__ float silu_f(float x) { return x * sigmoid_f(x); }
__device__ __forceinline__ float gelu_tanh_f(float x) { const float u = 0.7978845608028654f * (x + 0.044715f * x * x * x); return x * frcp(1.0f + fexp2(-2.0f * LOG2E * u)); }

__device__ __forceinline__ void st16_wt(void* p, u32x4 v) { asm volatile("global_store_dwordx4 %0, %1, off sc0 sc1" :: "v"(p), "v"(v) : "memory"); }
__device__ __forceinline__ void st8_wt(void* p, u32x2 v) { asm volatile("global_store_dwordx2 %0, %1, off sc0 sc1" :: "v"(p), "v"(v) : "memory"); }
__device__ __forceinline__ void st4_wt(void* p, float v) { asm volatile("global_store_dword %0, %1, off sc0 sc1" :: "v"(p), "v"(v) : "memory"); }
__device__ __forceinline__ float row_rstd(const float* ssp, int row) { const f32x4 p = *(const f32x4*)(ssp + (size_t)row * 4); return rsqrtf(((p[0] + p[1]) + (p[2] + p[3])) * (1.0f / D) + NORM_EPS); }

namespace pg8 {
constexpr int BM = 256, BK = 64, HALF = 128, HTB = HALF * BK * 2, STAGE_BYTES = 8 * HTB, NXCD = 8, WGM = 8;
__host__ __device__ __forceinline__ int lds_byte(int r, int c) { const int st = (r >> 4) * 2 + (c >> 5), rr = r & 15, cc = c & 31, ob = rr * 64 + cc * 2; return st * 1024 + (ob ^ (((ob >> 9) & 1) << 5)); }
__host__ __device__ __forceinline__ void stage_rc(int b, int& R, int& C) { const int st = b / 1024, sb = b % 1024, swz = sb ^ (((sb >> 9) & 1) << 5); R = (st >> 1) * 16 + swz / 64; C = (st & 1) * 32 + (swz % 64) / 2; }
__host__ __device__ __forceinline__ int perm32(int rho) { const int n = rho >> 4, i = rho & 15; return 8 * (i >> 2) + 4 * n + (i & 3); }

struct Unit { int pm, pn; };
struct Gemm { const bf16_t* A; const bf16_t* Bt; int M, N, K, lda; };

struct StaticOrder {
    int nM, nN, nwg, G, c;
    __device__ void init(int M_, int N_, int G_, int c_) { nM = M_ / BM; nN = N_ / BM; nwg = nM * nN; G = G_; c = c_; }
    __device__ bool next(int i, Unit& u) const {
        const long L = (long)i * G + c; if (L >= nwg) return false;
        int wgid = (int)L; { const int q = nwg / NXCD, r = nwg % NXCD, xcd = wgid % NXCD, off = wgid / NXCD; wgid = (xcd < r ? xcd * (q + 1) : r * (q + 1) + (xcd - r) * q) + off; }
        const int nig = WGM * nN, gid = wgid / nig, fm = gid * WGM, gsz = (nM - fm) < WGM ? (nM - fm) : WGM;
        u.pm = fm + ((wgid % nig) % gsz); u.pn = (wgid % nig) / gsz; return true;
    }
};
typedef __bf16 bf16x2_t __attribute__((ext_vector_type(2)));
__device__ __forceinline__ unsigned cvt_pk_bf16(float lo, float hi) { const f32x2 v = {lo, hi}; const bf16x2_t b = __builtin_convertvector(v, bf16x2_t); return __builtin_bit_cast(unsigned, b); }

template <class Epi>
__device__ __forceinline__ void gemm_phase(LAS unsigned char* lds, const Gemm g, const StaticOrder& S, const Epi& E) {
    int tid = threadIdx.x; asm volatile("" : "+v"(tid));
    const int wid = __builtin_amdgcn_readfirstlane(tid >> 6), lane = tid & 63, wr = wid >> 2, wc = wid & 3, fr = lane & 15, fq = lane >> 4;
    const int K = g.K, nt = K / BK, lda = g.lda;
    unsigned voffA[2], voffB[2];
#pragma unroll
    for (int i = 0; i < 2; ++i) { int R, C; stage_rc(tid * 16 + i * 8192, R, C); const int Rb = Epi::PERM ? ((R & ~31) + perm32(R & 31)) : R;
        voffA[i] = (unsigned)(R * lda + C) * 2u; voffB[i] = (unsigned)(Rb * K + C) * 2u; }
    const size_t kstep = (size_t)(BK * 2);
    const size_t hstepA = (size_t)HALF * lda * 2, hstepB = (size_t)HALF * K * 2;
    const size_t tstepA = 2 * hstepA, tstepB = 2 * hstepB;
    const unsigned ldsw = (unsigned)wid * 1024u;
    const int aoff = lds_byte(wr * 64 + fr, fq * 8), boff = lds_byte(wc * 32 + fr, fq * 8);
#define PG8_SA(b, h) (((b) * 2 + (h)) * HTB)
#define PG8_SB(b, h) ((4 + (b) * 2 + (h)) * HTB)
#define PG8_STAGE(bufoff, gbase, voff) do { _Pragma("unroll") for (int _i = 0; _i < 2; ++_i) \
        __builtin_amdgcn_global_load_lds((const unsigned*)((const char*)(gbase) + (voff)[_i]), (LAS unsigned*)(lds + (bufoff) + ldsw + _i * 8192), 16, 0, 0); } while (0)
#define PG8_LDA(dst, b, h) do { _Pragma("unroll") for (int m = 0; m < 4; ++m) _Pragma("unroll") for (int k = 0; k < 2; ++k) dst[m][k] = *(const LAS bf16x8*)(lds + PG8_SA(b, h) + aoff + m * 2048 + k * 1024); } while (0)
#define PG8_LDB(dst, b, h) do { _Pragma("unroll") for (int n = 0; n < 2; ++n) _Pragma("unroll") for (int k = 0; k < 2; ++k) dst[n][k] = *(const LAS bf16x8*)(lds + PG8_SB(b, h) + boff + n * 2048 + k * 1024); } while (0)
#define PG8_MMA(ai, bj, At, Bt) do { __builtin_amdgcn_s_setprio(1); _Pragma("unroll") for (int m = 0; m < 4; ++m) _Pragma("unroll") for (int n = 0; n < 2; ++n) _Pragma("unroll") for (int k = 0; k < 2; ++k) \
        acc[ai][bj][m][n] = __builtin_amdgcn_mfma_f32_16x16x32_bf16(Bt[n][k], At[m][k], acc[ai][bj][m][n], 0, 0, 0); __builtin_amdgcn_s_setprio(0); } while (0)
#define PG8_WAIT_V(n) asm volatile("s_waitcnt vmcnt(" #n ")" ::: "memory")
#define PG8_WAIT_L(n) asm volatile("s_waitcnt lgkmcnt(" #n ")" ::: "memory")
#define PG8_BAR __builtin_amdgcn_s_barrier()
#define PG8_SCHED __builtin_amdgcn_sched_barrier(0)
    Unit cur, nxt; int ui = 0;
    if (!S.next(0, cur)) return;
    f32x4 acc[2][2][4][2];
#pragma unroll
    for (int a = 0; a < 2; ++a)
#pragma unroll
        for (int b = 0; b < 2; ++b)
#pragma unroll
            for (int m = 0; m < 4; ++m)
#pragma unroll
                for (int n = 0; n < 2; ++n) acc[a][b][m][n] = (f32x4){0.f, 0.f, 0.f, 0.f};
    bf16x8 At[4][2], B0[2][2], B1[2][2];
    const char* cA = (const char*)g.A + (size_t)cur.pm * tstepA; const char* cB = (const char*)g.Bt + (size_t)cur.pn * tstepB;
    PG8_STAGE(PG8_SB(0, 0), cB, voffB); PG8_STAGE(PG8_SB(0, 1), cB + hstepB, voffB); PG8_STAGE(PG8_SA(0, 0), cA, voffA); PG8_STAGE(PG8_SA(0, 1), cA + hstepA, voffA);
    if (wr == 1) PG8_BAR;
    PG8_WAIT_V(2); PG8_BAR;
    PG8_STAGE(PG8_SB(1, 0), cB + kstep, voffB); PG8_STAGE(PG8_SA(1, 0), cA + kstep, voffA); PG8_STAGE(PG8_SB(1, 1), cB + hstepB + kstep, voffB);
    PG8_WAIT_V(6); PG8_BAR;
    for (;;) {
        const bool has_next = S.next(ui + 1, nxt);
        const char* nA = has_next ? (const char*)g.A + (size_t)nxt.pm * tstepA : cA; const char* nB = has_next ? (const char*)g.Bt + (size_t)nxt.pn * tstepB : cB;
        for (int t = 0; t < nt; t += 2) {
            const bool last = (t == nt - 2);
            const char* a1 = cA + (size_t)(t + 1) * kstep;
            const char* a2 = last ? nA : cA + (size_t)(t + 2) * kstep; const char* b2 = last ? nB : cB + (size_t)(t + 2) * kstep;
            const char* a3 = a2 + kstep; const char* b3 = b2 + kstep;
            PG8_LDB(B0, 0, 0); PG8_LDB(B1, 0, 1); PG8_SCHED; PG8_LDA(At, 0, 0); PG8_STAGE(PG8_SA(1, 1), a1 + hstepA, voffA);
            PG8_WAIT_V(8); PG8_WAIT_L(0); PG8_BAR; PG8_MMA(0, 0, At, B0); PG8_MMA(0, 1, At, B1); PG8_BAR; PG8_SCHED;
            PG8_LDA(At, 0, 1); PG8_STAGE(PG8_SB(0, 0), b2, voffB); PG8_STAGE(PG8_SB(0, 1), b2 + hstepB, voffB); PG8_STAGE(PG8_SA(0, 0), a2, voffA);
            PG8_WAIT_V(8); PG8_WAIT_L(0); PG8_BAR; PG8_MMA(1, 0, At, B0); PG8_MMA(1, 1, At, B1); PG8_BAR; PG8_SCHED;
            PG8_LDB(B0, 1, 0); PG8_LDB(B1, 1, 1); PG8_SCHED; PG8_LDA(At, 1, 0); PG8_STAGE(PG8_SA(0, 1), a2 + hstepA, voffA);
            PG8_WAIT_V(8); PG8_WAIT_L(0); PG8_BAR; PG8_MMA(0, 0, At, B0); PG8_MMA(0, 1, At, B1); PG8_BAR; PG8_SCHED;
            PG8_LDA(At, 1, 1); PG8_STAGE(PG8_SB(1, 0), b3, voffB); PG8_STAGE(PG8_SB(1, 1), b3 + hstepB, voffB); PG8_STAGE(PG8_SA(1, 0), a3, voffA);
            PG8_WAIT_V(8); PG8_WAIT_L(0); PG8_BAR; PG8_MMA(1, 0, At, B0); PG8_MMA(1, 1, At, B1); PG8_BAR; PG8_SCHED;
        }
        if (wr == 0) PG8_BAR;
        E(acc, cur, wr, wc, fr, fq);
        if (!has_next) break;
#pragma unroll
        for (int a = 0; a < 2; ++a)
#pragma unroll
            for (int b = 0; b < 2; ++b)
#pragma unroll
                for (int m = 0; m < 4; ++m)
#pragma unroll
                    for (int n = 0; n < 2; ++n) acc[a][b][m][n] = (f32x4){0.f, 0.f, 0.f, 0.f};
        cur = nxt; cA = nA; cB = nB; ++ui;
        if (wr == 1) PG8_BAR;
    }
    PG8_WAIT_V(0);
    PG8_BAR;
#undef PG8_SA
#undef PG8_SB
#undef PG8_STAGE
#undef PG8_LDA
#undef PG8_LDB
#undef PG8_MMA
#undef PG8_WAIT_V
#undef PG8_WAIT_L
#undef PG8_BAR
#undef PG8_SCHED
}

struct EpiSwiglu {
    static constexpr bool PERM = true;
    bf16_t* H; const float* ss;
    __device__ __forceinline__ void operator()(const f32x4 (&acc)[2][2][4][2], const Unit& u, int wr, int wc, int fr, int fq) const {
        const int row0 = u.pm * BM + wr * 64 + fr, col0 = u.pn * 128 + wc * 32 + 8 * fq;
#pragma unroll
        for (int ai = 0; ai < 2; ++ai)
#pragma unroll
            for (int m = 0; m < 4; ++m) { const int row = row0 + ai * HALF + m * 16; const float r = row_rstd(ss, row);
                float h[8];
#pragma unroll
                for (int n = 0; n < 2; ++n)
#pragma unroll
                    for (int e = 0; e < 4; ++e) { const float a = acc[ai][0][m][n][e] * r, b = acc[ai][1][m][n][e] * r; h[n * 4 + e] = silu_f(a) * b; }
                u32x4 w; w.x = cvt_pk_bf16(h[0], h[1]); w.y = cvt_pk_bf16(h[2], h[3]); w.z = cvt_pk_bf16(h[4], h[5]); w.w = cvt_pk_bf16(h[6], h[7]);
                *(u32x4*)(H + (size_t)row * F + col0) = w; }
    }
};
struct EpiResid {
    static constexpr bool PERM = false;
    const float* base; float* out; bf16_t* xb; float* ssn; float scale; LAS float* red;
    __device__ __forceinline__ void operator()(const f32x4 (&acc)[2][2][4][2], const Unit& u, int wr, int wc, int fr, int fq) const {
        const int row0 = u.pm * BM + wr * 64 + fr, col0 = u.pn * BM + wc * 32 + 4 * fq;
#pragma unroll
        for (int ai = 0; ai < 2; ++ai)
#pragma unroll
            for (int m = 0; m < 4; ++m) { const int row = row0 + ai * HALF + m * 16; const size_t off = (size_t)row * D + col0; float q = 0.f;
#pragma unroll
                for (int bj = 0; bj < 2; ++bj)
#pragma unroll
                    for (int n = 0; n < 2; ++n) { const size_t o2 = off + bj * HALF + n * 16; const f32x4 b = *(const f32x4*)(base + o2); const f32x4 o = b + acc[ai][bj][m][n] * scale;
                        *(f32x4*)(out + o2) = o; u32x2 w; w.x = cvt_pk_bf16(o[0], o[1]); w.y = cvt_pk_bf16(o[2], o[3]); *(u32x2*)(xb + o2) = w;
                        q += (o[0] * o[0] + o[1] * o[1]) + (o[2] * o[2] + o[3] * o[3]); }
                q += __shfl_xor(q, 16); q += __shfl_xor(q, 32);
                if (fq == 0) red[(ai * HALF + wr * 64 + m * 16 + fr) * 4 + wc] = q;
                asm volatile("" ::: "memory"); }
        asm volatile("s_waitcnt lgkmcnt(0)" ::: "memory"); __builtin_amdgcn_s_barrier(); asm volatile("" ::: "memory");
        if (wr == 0) { const int t = wc * 64 + fq * 16 + fr; const f32x4 p = *(const LAS f32x4*)(red + t * 4);
            ssn[((size_t)u.pm * BM + t) * 4 + u.pn] = (p[0] + p[1]) + (p[2] + p[3]); }
    }
};
struct EpiInproj {
    static constexpr bool PERM = true;
    bf16_t* P; const float* ss;
    __device__ __forceinline__ void operator()(const f32x4 (&acc)[2][2][4][2], const Unit& u, int wr, int wc, int fr, int fq) const {
        const int row0 = u.pm * BM + wr * 64 + fr, col0 = u.pn * BM + wc * 32 + 8 * fq;
        const int act = (u.pn < 4) ? 1 : ((u.pn >= 15) ? 2 : 0);
#pragma unroll
        for (int ai = 0; ai < 2; ++ai)
#pragma unroll
            for (int m = 0; m < 4; ++m) { const int row = row0 + ai * HALF + m * 16; const float r = row_rstd(ss, row);
#pragma unroll
                for (int bj = 0; bj < 2; ++bj) { float h[8];
#pragma unroll
                    for (int n = 0; n < 2; ++n)
#pragma unroll
                        for (int e = 0; e < 4; ++e) { float v = acc[ai][bj][m][n][e] * r; if (act == 1) v = gelu_tanh_f(v); else if (act == 2) v = silu_f(v); h[n * 4 + e] = v; }
                    u32x4 w; w.x = cvt_pk_bf16(h[0], h[1]); w.y = cvt_pk_bf16(h[2], h[3]); w.z = cvt_pk_bf16(h[4], h[5]); w.w = cvt_pk_bf16(h[6], h[7]);
#if MK_WTIN
                    asm volatile("global_store_dwordx4 %0, %1, off sc0 sc1" :: "v"(P + (size_t)row * PW + col0 + bj * HALF), "v"(w) : "memory"); } }
#else
                    *(u32x4*)(P + (size_t)row * PW + col0 + bj * HALF) = w; } }
#endif
    }
};
struct EpiGate {
    static constexpr bool PERM = true;
    bf16_t* G; const float* ss; const float* bias; int ld; float* dbg32;
    __device__ __forceinline__ void operator()(const f32x4 (&acc)[2][2][4][2], const Unit& u, int wr, int wc, int fr, int fq) const {
        const int row0 = u.pm * BM + wr * 64 + fr, col0 = u.pn * BM + wc * 32 + 8 * fq;
#pragma unroll
        for (int ai = 0; ai < 2; ++ai)
#pragma unroll
            for (int m = 0; m < 4; ++m) { const int row = row0 + ai * HALF + m * 16; const float r = row_rstd(ss, row);
#pragma unroll
                for (int bj = 0; bj < 2; ++bj) { float h[8]; const f32x4 b0 = *(const f32x4*)(bias + col0 + bj * HALF), b1 = *(const f32x4*)(bias + col0 + bj * HALF + 4);
#pragma unroll
#ifdef MK_X1
                    for (int e = 0; e < 4; ++e) { h[e] = sigmoid_f(acc[ai][bj][m][0][e] * 0.03f + 0.f * (r + b0[e])); h[4 + e] = sigmoid_f(acc[ai][bj][m][1][e] * 0.03f + 0.f * b1[e]); }
#else
                    for (int e = 0; e < 4; ++e) { h[e] = sigmoid_f(acc[ai][bj][m][0][e] * r + b0[e]); h[4 + e] = sigmoid_f(acc[ai][bj][m][1][e] * r + b1[e]); }
#endif
                    u32x4 w; w.x = cvt_pk_bf16(h[0], h[1]); w.y = cvt_pk_bf16(h[2], h[3]); w.z = cvt_pk_bf16(h[4], h[5]); w.w = cvt_pk_bf16(h[6], h[7]);
#if MK_WTG
                    asm volatile("global_store_dwordx4 %0, %1, off sc0 sc1" :: "v"(G + (size_t)row * ld + col0 + bj * HALF), "v"(w) : "memory");
#else
                    *(u32x4*)(G + (size_t)row * ld + col0 + bj * HALF) = w;
#endif
                    if (dbg32) { *(f32x4*)(dbg32 + (size_t)row * D + col0 + bj * HALF) = (f32x4){h[0], h[1], h[2], h[3]}; *(f32x4*)(dbg32 + (size_t)row * D + col0 + bj * HALF + 4) = (f32x4){h[4], h[5], h[6], h[7]}; } }
                asm volatile("" ::: "memory"); }
    }
};
struct EpiMerge {
    static constexpr bool PERM = true;
    const bf16_t* G; bf16_t* Mg; int first, ld;
    __device__ __forceinline__ void operator()(const f32x4 (&acc)[2][2][4][2], const Unit& u, int wr, int wc, int fr, int fq) const {
        const int row0 = u.pm * BM + wr * 64 + fr, col0 = u.pn * BM + wc * 32 + 8 * fq;
#pragma unroll
        for (int ai = 0; ai < 2; ++ai)
#pragma unroll
            for (int m = 0; m < 4; ++m) { const int row = row0 + ai * HALF + m * 16;
#pragma unroll
                for (int bj = 0; bj < 2; ++bj) { const size_t off = (size_t)row * ld + col0 + bj * HALF;
                    const u32x4 gv = *(const u32x4*)(G + off); u32x4 mv = (u32x4){0u, 0u, 0u, 0u}; if (!first) mv = *(const u32x4*)(Mg + off);
                    float h[8];
#pragma unroll
                    for (int n = 0; n < 2; ++n) { const unsigned g0 = n ? gv.z : gv.x, g1 = n ? gv.w : gv.y, m0 = n ? mv.z : mv.x, m1 = n ? mv.w : mv.y;
                        h[n * 4 + 0] = bflo(m0) + bflo(g0) * acc[ai][bj][m][n][0]; h[n * 4 + 1] = bfhi(m0) + bfhi(g0) * acc[ai][bj][m][n][1];
                        h[n * 4 + 2] = bflo(m1) + bflo(g1) * acc[ai][bj][m][n][2]; h[n * 4 + 3] = bfhi(m1) + bfhi(g1) * acc[ai][bj][m][n][3]; }
                    u32x4 w; w.x = cvt_pk_bf16(h[0], h[1]); w.y = cvt_pk_bf16(h[2], h[3]); w.z = cvt_pk_bf16(h[4], h[5]); w.w = cvt_pk_bf16(h[6], h[7]);
                    *(u32x4*)(Mg + off) = w; }
                asm volatile("" ::: "memory"); }
    }
};
}

template <int KSTEPS>
__device__ __forceinline__ f32x4 mma_k(const LAS unsigned char* pa, const LAS unsigned char* pb, f32x4 acc) {
#pragma unroll
    for (int s = 0; s < KSTEPS; ++s) { const bf16x8 a = *(const LAS bf16x8*)(pa + s * 64); const bf16x8 b = *(const LAS bf16x8*)(pb + s * 64);
        acc = __builtin_amdgcn_mfma_f32_16x16x32_bf16(a, b, acc, 0, 0, 0); }
    return acc;
}
__device__ __forceinline__ void lds_st16(LAS unsigned char* p, unsigned v) { *(LAS unsigned short*)p = (unsigned short)v; }

__device__ __forceinline__ void unit_gmlp(LAS unsigned char* L, bf16_t* P, const bf16_t* WSb, const float* vnorm, const float* bs, int ci, int tid) {
    asm volatile("" : "+v"(tid));
    const int lane = tid & 63, wid = tid >> 6, l15 = lane & 15, lq = lane >> 4;
    constexpr int PT = 272;
    LAS unsigned char* Wl = L; LAS unsigned char* VT = L + 34816; LAS float* rs = (LAS float*)(L + 69632);
    bf16_t* Prow = P + (size_t)ci * 128 * PW;
    {
        const int t = tid >> 2, part = tid & 3; const bf16_t* src = Prow + (size_t)t * PW + C_AV + part * 128; float s = 0.f;
#pragma unroll 4
        for (int i = 0; i < 16; ++i) { const u32x4 v = __builtin_nontemporal_load((const u32x4*)(src + 8 * i));
            s += bflo(v.x) * bflo(v.x) + bfhi(v.x) * bfhi(v.x) + bflo(v.y) * bflo(v.y) + bfhi(v.y) * bfhi(v.y) + bflo(v.z) * bflo(v.z) + bfhi(v.z) * bfhi(v.z) + bflo(v.w) * bflo(v.w) + bfhi(v.w) * bfhi(v.w); }
        s += __shfl_xor(s, 1); s += __shfl_xor(s, 2);
        if (part == 0) rs[t] = rsqrtf(s * (1.0f / 512.0f) + NORM_EPS);
    }
    __syncthreads();
    for (int g = 0; g < 4; ++g) {
        for (int i = tid; i < 2048; i += 512) { const int r = i >> 4, c = i & 15; *(LAS u32x4*)(Wl + r * PT + c * 16) = __builtin_nontemporal_load((const u32x4*)(WSb + g * 16384 + r * 128 + c * 8)); }
        {   const int s = tid & 127, dq = tid >> 7; const bf16_t* src = Prow + (size_t)s * PW + C_AV + g * 128 + dq * 32; const float r = rs[s]; const float* gn = vnorm + g * 128 + dq * 32;
#pragma unroll
            for (int i = 0; i < 4; ++i) { const u32x4 v = __builtin_nontemporal_load((const u32x4*)(src + 8 * i)); const unsigned w[4] = {v.x, v.y, v.z, v.w};
#pragma unroll
                for (int k = 0; k < 4; ++k) { const int d = dq * 32 + 8 * i + 2 * k;
                    lds_st16(VT + d * PT + s * 2, f2bf(bflo(w[k]) * r * gn[8 * i + 2 * k])); lds_st16(VT + (d + 1) * PT + s * 2, f2bf(bfhi(w[k]) * r * gn[8 * i + 2 * k + 1])); } }
        }
        __syncthreads();
        {   const LAS unsigned char* pa = VT + (16 * wid + l15) * PT + lq * 16;
            for (int tt = 0; tt < 8; ++tt) { const LAS unsigned char* pb = Wl + (16 * tt + l15) * PT + lq * 16;
                const f32x4 acc = mma_k<4>(pa, pb, (f32x4){0.f, 0.f, 0.f, 0.f});
                const int t = 16 * tt + l15, d = 16 * wid + 4 * lq; const float b = bs[g * 128 + t];
                bf16_t* up = Prow + (size_t)t * PW + C_AU + g * 128 + d; const u32x2 uv = __builtin_nontemporal_load((const u32x2*)up);
                u32x2 o; o.x = pk2(bflo(uv.x) * (acc[0] + b), bfhi(uv.x) * (acc[1] + b)); o.y = pk2(bflo(uv.y) * (acc[2] + b), bfhi(uv.y) * (acc[3] + b));
                *(u32x2*)up = o; }
        }
        __syncthreads();
    }
}

__device__ __forceinline__ void unit_attn(LAS unsigned char* L, bf16_t* P, const float* sinks, int ci, int tid) {
    asm volatile("" : "+v"(tid));
    const int lane = tid & 63, wid = tid >> 6, l15 = lane & 15, lq = lane >> 4;
    constexpr int PK = 144, PV = 528, PP = 336;
    LAS unsigned char* Kl = L; LAS unsigned char* VT = L + 36864; LAS unsigned char* Pl = L + 70656 + wid * 5376;
    const int n = ci & 127; const long rowbase = (long)ci * 128 - 128;
    for (int kvh = 0; kvh < 2; ++kvh) {
        for (int i = tid; i < 2048; i += 512) { const int r = i >> 3, c = i & 7; u32x4 v = (u32x4){0u, 0u, 0u, 0u};
            if (n > 0 || r >= 128) v = __builtin_nontemporal_load((const u32x4*)(P + (size_t)(rowbase + r) * PW + C_BK + kvh * 64 + c * 8));
            *(LAS u32x4*)(Kl + r * PK + c * 16) = v; }
        {   const int k = tid & 255, dh = tid >> 8; const bool ok = (n > 0 || k >= 128);
#pragma unroll
            for (int i = 0; i < 4; ++i) { u32x4 v = (u32x4){0u, 0u, 0u, 0u}; if (ok) v = __builtin_nontemporal_load((const u32x4*)(P + (size_t)(rowbase + k) * PW + C_BV + kvh * 64 + dh * 32 + 8 * i));
                const unsigned w[4] = {v.x, v.y, v.z, v.w};
#pragma unroll
                for (int q = 0; q < 4; ++q) { const int d = dh * 32 + 8 * i + 2 * q; lds_st16(VT + d * PV + k * 2, w[q] & 0xffffu); lds_st16(VT + (d + 1) * PV + k * 2, w[q] >> 16); } }
        }
        __syncthreads();
        for (int it = 0; it < 4; ++it) {
            const int g = wid >> 1, qt = (wid & 1) * 4 + it, h = kvh * 4 + g;
            const float slope = fexp2(-(float)(h + 1)), sink = sinks[h];
            const size_t qrow = (size_t)ci * 128 + 16 * qt + l15;
            bf16_t* qp = P + qrow * PW + C_BQ + h * 64;
            const bf16x8 q0 = *(const bf16x8*)(qp + lq * 8), q1 = *(const bf16x8*)(qp + 32 + lq * 8);
            const int kt0 = qt & ~1;
            f32x4 sc[10];
#pragma unroll
            for (int i = 0; i < 10; ++i) { const LAS unsigned char* pa = Kl + (16 * (kt0 + i) + l15) * PK + lq * 16;
                f32x4 a = __builtin_amdgcn_mfma_f32_16x16x32_bf16(*(const LAS bf16x8*)pa, q0, (f32x4){0.f, 0.f, 0.f, 0.f}, 0, 0, 0);
                sc[i] = __builtin_amdgcn_mfma_f32_16x16x32_bf16(*(const LAS bf16x8*)(pa + 64), q1, a, 0, 0, 0); }
            const int qpos = 128 + 16 * qt + l15; float mx = sink;
#pragma unroll
            for (int i = 0; i < 10; ++i)
#pragma unroll
                for (int j = 0; j < 4; ++j) { const int kpos = 16 * (kt0 + i) + 4 * lq + j, dist = qpos - kpos; const bool valid = dist >= 0 && dist < 128 && (n > 0 || kpos >= 128);
                    const float s = valid ? sc[i][j] * 0.125f - slope * (float)dist : -INFINITY; sc[i][j] = s; mx = fmaxf(mx, s); }
            mx = fmaxf(mx, __shfl_xor(mx, 16)); mx = fmaxf(mx, __shfl_xor(mx, 32));
            float sum = 0.f;
#pragma unroll
            for (int i = 0; i < 10; ++i)
#pragma unroll
                for (int j = 0; j < 4; ++j) { const float p = fexp2((sc[i][j] - mx) * LOG2E); sc[i][j] = p; sum += p; }
            sum += __shfl_xor(sum, 16); sum += __shfl_xor(sum, 32);
            sum += fexp2((sink - mx) * LOG2E);
            const float inv = 1.0f / sum;
#pragma unroll
            for (int i = 0; i < 10; ++i) { u32x2 w; w.x = pk2(sc[i][0] * inv, sc[i][1] * inv); w.y = pk2(sc[i][2] * inv, sc[i][3] * inv);
                *(LAS u32x2*)(Pl + l15 * PP + (16 * i + 4 * lq) * 2) = w; }
            asm volatile("s_waitcnt lgkmcnt(0)" ::: "memory");
#pragma unroll
            for (int dt = 0; dt < 4; ++dt) { f32x4 acc = (f32x4){0.f, 0.f, 0.f, 0.f};
#pragma unroll
                for (int s5 = 0; s5 < 5; ++s5) { const bf16x8 a = *(const LAS bf16x8*)(VT + (16 * dt + l15) * PV + (16 * kt0 + 32 * s5 + 8 * lq) * 2);
                    const bf16x8 b = *(const LAS bf16x8*)(Pl + l15 * PP + (32 * s5 + 8 * lq) * 2);
                    acc = __builtin_amdgcn_mfma_f32_16x16x32_bf16(a, b, acc, 0, 0, 0); }
                u32x2 o; o.x = pk2(acc[0], acc[1]); o.y = pk2(acc[2], acc[3]);
                *(u32x2*)(qp + 16 * dt + 4 * lq) = o; }
            asm volatile("s_waitcnt lgkmcnt(0)" ::: "memory");
        }
        __syncthreads();
    }
}

__device__ __forceinline__ void unit_kv(LAS unsigned char* L, const bf16_t* P, bf16_t* KV, int u, int tid) {
    asm volatile("" : "+v"(tid));
    const int lane = tid & 63, wid = tid >> 6, l15 = lane & 15, lq = lane >> 4;
    constexpr int PT = 272;
    LAS unsigned char* vT = L; LAS unsigned char* kT = L + 69632;
    const int ci = u >> 2, h = u & 3;
    const float lg = log2f(1.0f - exp2f(-5.0f - (float)h));
    const int s = tid & 127, qd = tid >> 7;
    {   const bf16_t* src = P + ((size_t)ci * 128 + s) * PW + C_CV + h * 256 + qd * 64;
#pragma unroll
        for (int i = 0; i < 8; ++i) { const u32x4 v = __builtin_nontemporal_load((const u32x4*)(src + 8 * i)); const unsigned w[4] = {v.x, v.y, v.z, v.w};
#pragma unroll
            for (int q = 0; q < 4; ++q) { const int e = qd * 64 + 8 * i + 2 * q; lds_st16(vT + e * PT + s * 2, w[q] & 0xffffu); lds_st16(vT + (e + 1) * PT + s * 2, w[q] >> 16); } }
    }
    {   const bf16_t* src = P + ((size_t)ci * 128 + s) * PW + C_CK + h * 128 + qd * 32; const float kw = 0.08838834764831845f * fexp2(lg * (float)(127 - s));
#pragma unroll
        for (int i = 0; i < 4; ++i) { const u32x4 v = __builtin_nontemporal_load((const u32x4*)(src + 8 * i)); const unsigned w[4] = {v.x, v.y, v.z, v.w};
#pragma unroll
            for (int q = 0; q < 4; ++q) { const int d = qd * 32 + 8 * i + 2 * q; lds_st16(kT + d * PT + s * 2, f2bf(bflo(w[q]) * kw)); lds_st16(kT + (d + 1) * PT + s * 2, f2bf(bfhi(w[q]) * kw)); } }
    }
    __syncthreads();
    bf16_t* out = KV + (size_t)u * 32768;
    for (int ee = 0; ee < 2; ++ee) { const int et = 2 * wid + ee; const LAS unsigned char* pb = vT + (16 * et + l15) * PT + lq * 16;
#pragma unroll 2
        for (int dt = 0; dt < 8; ++dt) { const LAS unsigned char* pa = kT + (16 * dt + l15) * PT + lq * 16;
            const f32x4 acc = mma_k<4>(pa, pb, (f32x4){0.f, 0.f, 0.f, 0.f});
            u32x2 o; o.x = pk2(acc[0], acc[1]); o.y = pk2(acc[2], acc[3]);
            *(u32x2*)(out + (16 * et + l15) * 128 + 16 * dt + 4 * lq) = o; } }
    __syncthreads();
}

__device__ __forceinline__ void phase_scan(bf16_t* KV, int gtid, int gthreads) {
    for (int w = gtid; w < 32768; w += gthreads) {
        const int b = 0, h = (w >> 13) & 3, e4 = w & 8191;
        const float decay = exp2f(128.0f * log2f(1.0f - exp2f(-5.0f - (float)h)));
        float st0 = 0.f, st1 = 0.f, st2 = 0.f, st3 = 0.f;
        bf16_t* base = KV + ((size_t)(b * 128) * 4 + h) * 32768 + (size_t)e4 * 4;
        for (int n0 = 0; n0 < 128; n0 += 16) {
            u32x2 v[16];
#pragma unroll
            for (int i = 0; i < 16; ++i) v[i] = __builtin_nontemporal_load((const u32x2*)(base + (size_t)(n0 + i) * 4 * 32768));
#pragma unroll
            for (int i = 0; i < 16; ++i) { u32x2 o; o.x = pk2(st0, st1); o.y = pk2(st2, st3); *(u32x2*)(base + (size_t)(n0 + i) * 4 * 32768) = o;
                st0 = decay * st0 + bflo(v[i].x); st1 = decay * st1 + bfhi(v[i].x); st2 = decay * st2 + bflo(v[i].y); st3 = decay * st3 + bfhi(v[i].y); }
        }
    }
}

__device__ __forceinline__ void unit_ret(LAS unsigned char* L, bf16_t* P, const bf16_t* KV, const float* gn, int u, int tid) {
    asm volatile("" : "+v"(tid));
    const int lane = tid & 63, wid = tid >> 6, l15 = lane & 15, lq = lane >> 4;
    constexpr int PT = 272, R = 34816;
    LAS unsigned char* Ql = L; LAS unsigned char* Kl = L + R; LAS unsigned char* Pl = L + 2 * R; LAS unsigned char* Sl = L + 3 * R;
    const int ci = u >> 2, h = u & 3; const size_t row0 = (size_t)ci * 128;
    const float lg = log2f(1.0f - exp2f(-5.0f - (float)h));
    for (int i = tid; i < 2048; i += 512) { const int r = i >> 4, c = i & 15; const bf16_t* src = P + (row0 + r) * PW + h * 128 + c * 8;
        *(LAS u32x4*)(Ql + r * PT + c * 16) = __builtin_nontemporal_load((const u32x4*)(src + C_CQ)); *(LAS u32x4*)(Kl + r * PT + c * 16) = __builtin_nontemporal_load((const u32x4*)(src + C_CK)); }
    __syncthreads();
    const int t = 16 * wid + l15;
    {   const LAS unsigned char* pb = Ql + t * PT + lq * 16;
        for (int st = 0; st < 8; ++st) { f32x4 acc = (f32x4){0.f, 0.f, 0.f, 0.f};
            if (st <= wid) { const LAS unsigned char* pa = Kl + (16 * st + l15) * PT + lq * 16; acc = mma_k<4>(pa, pb, acc); }
            float v[4];
#pragma unroll
            for (int j = 0; j < 4; ++j) { const int s = 16 * st + 4 * lq + j; v[j] = (s <= t) ? acc[j] * 0.08838834764831845f * fexp2(lg * (float)(t - s)) : 0.f; }
            u32x2 w; w.x = pk2(v[0], v[1]); w.y = pk2(v[2], v[3]);
            *(LAS u32x2*)(Pl + t * PT + (16 * st + 4 * lq) * 2) = w; }
    }
    __syncthreads();
    f32x4 o[16];
    const float qw = fexp2(lg * (float)(t + 1));
#pragma unroll
    for (int hf = 0; hf < 2; ++hf) {
        {   const int s = tid & 127, eq = tid >> 7; const bf16_t* src = P + (row0 + s) * PW + C_CV + h * 256 + hf * 128 + eq * 32;
#pragma unroll
            for (int i = 0; i < 4; ++i) { const u32x4 v = __builtin_nontemporal_load((const u32x4*)(src + 8 * i)); const unsigned w[4] = {v.x, v.y, v.z, v.w};
#pragma unroll
                for (int q = 0; q < 4; ++q) { const int e = eq * 32 + 8 * i + 2 * q; lds_st16(Kl + e * PT + s * 2, w[q] & 0xffffu); lds_st16(Kl + (e + 1) * PT + s * 2, w[q] >> 16); } }
        }
        for (int i = tid; i < 2048; i += 512) { const int r = i >> 4, c = i & 15; *(LAS u32x4*)(Sl + r * PT + c * 16) = __builtin_nontemporal_load((const u32x4*)(KV + (size_t)u * 32768 + (hf * 128 + r) * 128 + c * 8)); }
        __syncthreads();
        const LAS unsigned char* pbP = Pl + t * PT + lq * 16; const LAS unsigned char* pbQ = Ql + t * PT + lq * 16;
#pragma unroll
        for (int et = 0; et < 8; ++et) { const LAS unsigned char* paV = Kl + (16 * et + l15) * PT + lq * 16; const LAS unsigned char* paS = Sl + (16 * et + l15) * PT + lq * 16;
            const f32x4 ai = mma_k<4>(paV, pbP, (f32x4){0.f, 0.f, 0.f, 0.f}); const f32x4 ac = mma_k<4>(paS, pbQ, (f32x4){0.f, 0.f, 0.f, 0.f});
            o[hf * 8 + et] = ai + ac * qw; }
        __syncthreads();
    }
    float sum = 0.f;
#pragma unroll
    for (int i = 0; i < 16; ++i) sum += (o[i][0] + o[i][1]) + (o[i][2] + o[i][3]);
    sum += __shfl_xor(sum, 16); sum += __shfl_xor(sum, 32);
    const float mean = sum * (1.0f / 256.0f); float var = 0.f;
#pragma unroll
    for (int i = 0; i < 16; ++i) { const f32x4 dd = o[i] - mean; var += (dd[0] * dd[0] + dd[1] * dd[1]) + (dd[2] * dd[2] + dd[3] * dd[3]); }
    var += __shfl_xor(var, 16); var += __shfl_xor(var, 32);
    const float rstd = rsqrtf(var * (1.0f / 256.0f) + GN_EPS);
#pragma unroll
    for (int i = 0; i < 16; ++i) { const int e = 16 * i + 4 * lq; bf16_t* gp = P + (row0 + t) * PW + C_CG + h * 256 + e; const u32x2 gv = __builtin_nontemporal_load((const u32x2*)gp); const f32x4 gg = *(const f32x4*)(gn + h * 256 + e);
        u32x2 w; w.x = pk2((o[i][0] - mean) * rstd * gg[0] * bflo(gv.x), (o[i][1] - mean) * rstd * gg[1] * bfhi(gv.x));
        w.y = pk2((o[i][2] - mean) * rstd * gg[2] * bflo(gv.y), (o[i][3] - mean) * rstd * gg[3] * bfhi(gv.y));
        *(u32x2*)gp = w; if ((i & 3) == 3) asm volatile("" ::: "memory"); }
    __syncthreads();
}

__device__ __forceinline__ void transpose_item(const float* W, int K, int N, bf16_t* WT, const float* gk, bool swiglu, LAS float* scr, int item, int lane) {
    const int nblk = N / 32, kb = item / nblk, nb = item % nblk, k0 = 64 * kb, n0 = 32 * nb;
#pragma unroll 8
    for (int i = 0; i < 32; ++i) { const int kk = 2 * i + (lane >> 5); float v = W[(size_t)(k0 + kk) * N + n0 + (lane & 31)]; if (gk) v *= gk[k0 + kk]; scr[kk * 33 + (lane & 31)] = v; }
    asm volatile("s_waitcnt lgkmcnt(0)" ::: "memory");
    int d0 = n0; if (swiglu) { const int bj = n0 / F, rem = n0 % F; d0 = 256 * (rem / 128) + 128 * bj + (rem % 128); }
    const int c = lane & 7;
#pragma unroll
    for (int j = 0; j < 4; ++j) { const int n = (lane >> 3) + 8 * j; const LAS float* s = scr + (8 * c) * 33 + n;
        u32x4 o; o.x = pk2(s[0 * 33], s[1 * 33]); o.y = pk2(s[2 * 33], s[3 * 33]); o.z = pk2(s[4 * 33], s[5 * 33]); o.w = pk2(s[6 * 33], s[7 * 33]);
        *(u32x4*)(WT + (size_t)(d0 + n) * K + k0 + 8 * c) = o; }
    asm volatile("s_waitcnt lgkmcnt(0)" ::: "memory");
}

struct Args { const float* in[20]; float* out; unsigned char* ws; int ph_lo, ph_hi; };

constexpr int LDS_BYTES = 147456;

__global__ void __launch_bounds__(512, 2) mk_fwd(Args a) {
    extern __shared__ __attribute__((aligned(16))) unsigned char lds_raw[];
    LAS unsigned char* L = (LAS unsigned char*)lds_raw;
#ifndef MK_STOP
#define MK_STOP NPHASES
#endif
    for (int pidx = a.ph_lo; pidx < a.ph_hi; ++pidx) {
        const int ph = (!MK_MULTI && MK_STOP < NPHASES && pidx == a.ph_hi - 1) ? NPHASES - 1 : pidx;
        int tid = threadIdx.x; asm volatile("" : "+v"(tid));
        int bid = blockIdx.x; asm volatile("" : "+s"(bid));
        unsigned char* ws = a.ws; asm volatile("" : "+s"(ws));
        const int lane = tid & 63, wave = __builtin_amdgcn_readfirstlane(tid >> 6);
        const int G = gridDim.x;
        float* SS = (float*)(ws + WS_SSP);
        bf16_t* WB = (bf16_t*)(ws + WS_WB);
        bf16_t* XB = (bf16_t*)(ws + WS_XB);
        bf16_t* KV = (bf16_t*)(ws + WS_KV);
        bf16_t* P = (bf16_t*)(ws + WS_P);
        bf16_t* H = P;
        float* OUT = a.out;
        const int l = ph / NPH_LAYER, k0 = (ph == NPHASES - 1) ? 99 : ph % NPH_LAYER;
        const int bsel = (k0 >= 3 && k0 <= 14) ? (k0 - 3) / 6 : 0;
        const int k = (k0 >= 3 && k0 <= 14) ? 3 + (k0 - 3) % 6 : k0;
        const size_t rowoff = (size_t)bsel * MH;
#if MK_GOVL
        bf16_t* Gt = P + C_GT; bf16_t* Mg = P + C_MG; const int ldg = PW;
#else
        bf16_t* Gt = (bf16_t*)(ws + WS_G) + rowoff * D; bf16_t* Mg = (bf16_t*)(ws + WS_MG) + rowoff * D; const int ldg = D;
#endif
        if (k == 0) {
            int lane_o = lane; asm volatile("" : "+v"(lane_o));
            LAS float* scr = (LAS float*)(L + wave * 16384);
            const int gw = bid * 8 + wave, NGW = G * 8;
            for (int it = gw; it < 13952; it += NGW) {
                int r = it; const float* W; const float* gk = nullptr; bf16_t* WT; int K_, N_; bool sw = false;
                if (r < 2816) { W = a.in[2] + (size_t)l * D * 2 * F; K_ = D; N_ = 2 * F; WT = WB + O_W1IN; gk = a.in[1] + l * D; sw = true; }
                else if ((r -= 2816) < 1408) { W = a.in[3] + (size_t)l * F * D; K_ = F; N_ = D; WT = WB + O_W1OUT; }
                else if ((r -= 1408) < 3968) { W = a.in[5] + (size_t)l * D * 7936; K_ = D; N_ = 7936; WT = WB + O_WIN; gk = a.in[4] + l * D; }
                else if ((r -= 3968) < 256) { W = a.in[12] + (size_t)l * 512 * D; K_ = 512; N_ = D; WT = WB + O_WBA; }
                else if ((r -= 256) < 256) { W = a.in[13] + (size_t)l * 512 * D; K_ = 512; N_ = D; WT = WB + O_WBB; }
                else if ((r -= 256) < 512) { W = a.in[14] + (size_t)l * D * D; K_ = D; N_ = D; WT = WB + O_WBC; }
                else if ((r -= 512) < 512) { W = a.in[15] + (size_t)l * D * D; K_ = D; N_ = D; WT = WB + O_WOUT; }
                else if ((r -= 512) < 2816) { W = a.in[17] + (size_t)l * D * 2 * F; K_ = D; N_ = 2 * F; WT = WB + O_W2IN; gk = a.in[16] + l * D; sw = true; }
                else { r -= 2816; W = a.in[18] + (size_t)l * F * D; K_ = F; N_ = D; WT = WB + O_W2OUT; }
                transpose_item(W, K_, N_, WT, gk, sw, scr, r, lane_o);
            }
            {
                const float* wsrc = a.in[8] + (size_t)l * 65536;
                for (int i = bid * 512 + tid; i < 65536; i += G * 512) { const int tt = (i >> 7) & 127, s = i & 127; WB[O_WS + i] = (bf16_t)f2bf(s <= tt ? wsrc[i] : 0.f); }
            }
            if (l == 0) {
                const float* x = a.in[0];
                for (int m = gw; m < M; m += NGW) { const f32x4* xr = (const f32x4*)(x + (size_t)m * D) + lane; float s = 0.f; u32x2* o8 = (u32x2*)(XB + (size_t)m * D) + lane;
#pragma unroll
                    for (int j = 0; j < 4; ++j) { const f32x4 v = xr[64 * j]; s += (v[0] * v[0] + v[1] * v[1]) + (v[2] * v[2] + v[3] * v[3]); u32x2 w; w.x = pk2(v[0], v[1]); w.y = pk2(v[2], v[3]); o8[64 * j] = w; }
#pragma unroll
                    for (int o = 1; o < 64; o <<= 1) s += __shfl_xor(s, o);
                    if (lane == 0) *(f32x4*)(SS + (size_t)m * 4) = (f32x4){s, 0.f, 0.f, 0.f}; }
            }
            __syncthreads();
        } else if (k == 1 || k == 15) {
            pg8::Gemm g{XB, WB + (k == 1 ? O_W1IN : O_W2IN), M, 2 * F, D, D}; pg8::StaticOrder S; S.init(M, 2 * F, G, bid);
            pg8::EpiSwiglu E{H, SS + (size_t)(3 * l + (k == 1 ? 0 : 2)) * M * 4};
            pg8::gemm_phase<pg8::EpiSwiglu>(L, g, S, E);
        } else if (k == 2 || k == 16) {
            pg8::Gemm g{H, WB + (k == 2 ? O_W1OUT : O_W2OUT), M, D, F, F}; pg8::StaticOrder S; S.init(M, D, G, bid);
            const int sidx = 3 * l + (k == 2 ? 1 : 3);
            pg8::EpiResid E{(l == 0 && k == 2) ? a.in[0] : (const float*)OUT, OUT, XB, SS + (size_t)sidx * M * 4, 0.5f, (LAS float*)(L + 131072)};
            pg8::gemm_phase<pg8::EpiResid>(L, g, S, E);
        } else if (k == 8) {
            pg8::Gemm g{Mg, WB + O_WOUT, MH, D, D, ldg}; pg8::StaticOrder S; S.init(MH, D, G, bid);
            pg8::EpiResid E{OUT + rowoff * D, OUT + rowoff * D, XB + rowoff * D, SS + (size_t)(3 * l + 2) * M * 4 + rowoff * 4, 1.0f, (LAS float*)(L + 131072)};
            pg8::gemm_phase<pg8::EpiResid>(L, g, S, E);
        } else if (k == 3) {
            pg8::Gemm g{XB + rowoff * D, WB + O_WIN, MH, PW, D, D}; pg8::StaticOrder S; S.init(MH, PW, G, bid);
            pg8::EpiInproj E{P, SS + (size_t)(3 * l + 1) * M * 4 + rowoff * 4};
            pg8::gemm_phase<pg8::EpiInproj>(L, g, S, E);
        } else if (k == 4) {
            for (int i = bid; i < 768; i += G) {
                if (i < 128) unit_attn(L, P, a.in[10] + l * 8, i, tid);
                else if (i < 256) unit_gmlp(L, P, WB + O_WS, a.in[7] + l * 512, a.in[9] + l * 512, i - 128, tid);
                else unit_kv(L, P, KV, i - 256, tid);
            }
        } else if (k == 5) {
            phase_scan(KV, bid * 512 + tid, G * 512);
        } else if (k == 6) {
            for (int i = bid; i < 512; i += G) unit_ret(L, P, KV, a.in[11] + l * 1024, i, tid);
        } else if (k == 7) {
            for (int br = 0; br < 3; ++br) {
                const int gi = (br == 0) ? 2 : (br - 1);
                if (2 * br >= MK_P7) break;
                {   pg8::Gemm g{XB + rowoff * D, WB + O_WIN + (size_t)(PW + gi * D) * D, MH, D, D, D}; pg8::StaticOrder S; S.init(MH, D, G, bid);
                    pg8::EpiGate E{Gt, SS + (size_t)(3 * l + 1) * M * 4 + rowoff * 4, a.in[6] + l * 3 * D + gi * D, ldg, (MK_X2) ? OUT + rowoff * D : nullptr};
                    pg8::gemm_phase<pg8::EpiGate>(L, g, S, E);
#if MK_T10
                    {
                        asm volatile("s_waitcnt vmcnt(0)" ::: "memory"); __syncthreads();
                        pg8::Unit uu; for (int ui = 0; S.next(ui, uu); ++ui)
                            for (int e = tid; e < 256 * 256; e += 512) { const int r = e >> 8, c = e & 255; const size_t row = (size_t)uu.pm * 256 + r, col = (size_t)uu.pn * 256 + c;
                                OUT[(rowoff + row) * D + col] = bflo((unsigned)Gt[row * ldg + col]); }
                    }
#endif
                }
                if (2 * br + 1 >= MK_P7) break;
                {   pg8::Gemm g; pg8::StaticOrder S; S.init(MH, D, G, bid);
                    if (br == 0) g = pg8::Gemm{P + C_CG, WB + O_WBC, MH, D, D, PW}; else if (br == 1) g = pg8::Gemm{P + C_AU, WB + O_WBA, MH, D, 512, PW}; else g = pg8::Gemm{P + C_BQ, WB + O_WBB, MH, D, 512, PW};
                    pg8::EpiMerge E{Gt, Mg, br == 0 ? 1 : 0, ldg};
                    pg8::gemm_phase<pg8::EpiMerge>(L, g, S, E); }
            }
        } else {
#if MK_X2 || MK_T10
            continue;
#endif
#ifdef MK_DBG
#if MK_DELAY
            { const unsigned long long t0 = __builtin_amdgcn_s_memrealtime(); while (__builtin_amdgcn_s_memrealtime() - t0 < 30000ull) __builtin_amdgcn_s_sleep(32); }
            __builtin_amdgcn_fence(__ATOMIC_ACQUIRE, "agent"); asm volatile("s_waitcnt vmcnt(0)" ::: "memory"); __syncthreads();
#endif
            {   const bf16_t* src16 = (MK_DBG == 1) ? Gt : Mg;
                for (size_t i = (size_t)bid * 512 + tid; i < (size_t)M * D; i += (size_t)G * 512) { const size_t m = i >> 10, c = i & 1023; OUT[i] = (m < (size_t)MH) ? bflo((unsigned)src16[m * ldg + c]) : 0.f; } }
            continue;
#endif
            const int gw = bid * 8 + wave, NGW = G * 8; const float* fg = a.in[19]; const float* ss = SS + (size_t)6 * M * 4;
            for (int m = gw; m < M; m += NGW) { f32x4* xr = (f32x4*)(OUT + (size_t)m * D) + lane; const float r = row_rstd(ss, m);
#pragma unroll
                for (int j = 0; j < 4; ++j) { const f32x4 v = xr[64 * j]; const f32x4 gq = *((const f32x4*)fg + lane + 64 * j); xr[64 * j] = v * r * gq; } }
        }
        if (pidx + 1 < a.ph_hi) {
            asm volatile("s_waitcnt vmcnt(0) lgkmcnt(0)" ::: "memory");
            __syncthreads();
            if (threadIdx.x == 0) {
                __builtin_amdgcn_fence(__ATOMIC_RELEASE, "agent"); asm volatile("s_waitcnt vmcnt(0)" ::: "memory");
                unsigned* bar = (unsigned*)(ws + WS_BAR);
                const unsigned target = (unsigned)(pidx - a.ph_lo + 1) * (unsigned)G;
                __hip_atomic_fetch_add(bar, 1u, __ATOMIC_RELAXED, __HIP_MEMORY_SCOPE_AGENT);
                while (__hip_atomic_load(bar, __ATOMIC_RELAXED, __HIP_MEMORY_SCOPE_AGENT) < target) __builtin_amdgcn_s_sleep(2);
            }
            __syncthreads();
            __builtin_amdgcn_fence(__ATOMIC_ACQUIRE, "agent"); asm volatile("s_waitcnt vmcnt(0)" ::: "memory");
            __syncthreads();
#if MK_SCRUB
            {   const u32x4* sx = (const u32x4*)a.in[0] + (size_t)bid * 32768; u32x4 ax = (u32x4){0u, 0u, 0u, 0u};
#pragma unroll 8
                for (int i = threadIdx.x; i < 32768; i += 512) { const u32x4 v = sx[i]; ax.x ^= v.x; ax.y ^= v.y; ax.z ^= v.z; ax.w ^= v.w; }
                asm volatile("" :: "v"(ax.x), "v"(ax.y), "v"(ax.z), "v"(ax.w)); __syncthreads(); }
#endif
            cg::this_grid().sync();
            __builtin_amdgcn_fence(__ATOMIC_ACQUIRE, "agent"); asm volatile("s_waitcnt vmcnt(0)" ::: "memory"); __syncthreads();
        }
    }
}

extern "C" void kernel_launch(void* const* d_in, const int* in_sizes, int n_in, void* d_out, int out_size, void* d_ws, size_t ws_size, hipStream_t stream) {
    static int grid = 0;
    if (grid == 0) {
        if (n_in != 20 || in_sizes[0] != M * D || out_size != M * D || ws_size < WS_END) { fprintf(stderr, "kernel_launch: unexpected shapes / workspace (n_in %d, ws %zu, need %zu)\n", n_in, ws_size, (size_t)WS_END); grid = -1; return; }
        int dev = 0, cus = 0, per_cu = 0;
        hipGetDevice(&dev); hipDeviceGetAttribute(&cus, hipDeviceAttributeMultiprocessorCount, dev);
        if (hipFuncSetAttribute((const void*)mk_fwd, hipFuncAttributeMaxDynamicSharedMemorySize, LDS_BYTES) != hipSuccess) { fprintf(stderr, "kernel_launch: hipFuncSetAttribute failed\n"); grid = -1; return; }
        if (hipOccupancyMaxActiveBlocksPerMultiprocessor(&per_cu, (const void*)mk_fwd, 512, LDS_BYTES) != hipSuccess || per_cu < 1) { fprintf(stderr, "kernel_launch: occupancy query says %d\n", per_cu); per_cu = 1; }
        (void)hipGetLastError();
        grid = cus * 1;
    }
    if (grid < 0) return;
    (void)hipMemsetAsync((char*)d_ws + WS_BAR, 0, 4096, stream);
    Args a{};
    for (int i = 0; i < 20; ++i) a.in[i] = (const float*)d_in[i];
    a.out = (float*)d_out; a.ws = (unsigned char*)d_ws;
#if MK_MULTI
    for (int i = 0; i < ((MK_STOP < NPHASES) ? MK_STOP + 1 : NPHASES); ++i) { const int ph = (MK_STOP < NPHASES && i == MK_STOP) ? NPHASES - 1 : i; a.ph_lo = ph; a.ph_hi = ph + 1; hipLaunchKernelGGL(mk_fwd, dim3(grid), dim3(512), LDS_BYTES, stream, a); }
#else
    a.ph_lo = 0; a.ph_hi = (MK_STOP < NPHASES) ? MK_STOP + 1 : NPHASES;
    void* args[] = {&a};
    hipError_t e = hipLaunchCooperativeKernel((const void*)mk_fwd, dim3(grid), dim3(512), args, LDS_BYTES, stream);
    if (e != hipSuccess) fprintf(stderr, "cooperative launch failed: %s (grid %d)\n", hipGetErrorString(e), grid);
#endif
}
```

```cpp
#include <hip/hip_runtime.h>
#include <hip/hip_cooperative_groups.h>
#include <cstdio>
#include <cstdint>
namespace cg = cooperative_groups;

#ifndef MK_DELAY
#define MK_DELAY 0
#endif
#define MK_WTG 0
#define MK_T10 0
#ifndef MK_EXTRASYNC
#define MK_EXTRASYNC 0
#endif
#ifndef MK_REPPH
#define MK_REPPH -1
#endif
#ifndef MK_FENCE
#define MK_FENCE 4
#endif
#ifndef MK_REPBLK
#define MK_REPBLK 0
#endif
#ifndef MK_GOVL
#define MK_GOVL 0
#endif
#ifndef MK_SCRUB
#define MK_SCRUB 0
#endif
#ifndef MK_WTIN
#define MK_WTIN 0
#endif
#ifndef MK_X3
#define MK_X3 0
#endif
#ifndef MK_X2
#define MK_X2 0
#endif
#ifndef MK_P7
#define MK_P7 6
#endif
#ifndef MK_CGSYNC
#define MK_CGSYNC 0
#endif
#ifndef MK_MULTI
#define MK_MULTI 0
#endif

#define LAS __attribute__((address_space(3)))
typedef unsigned short bf16_t;
typedef short bf16x8 __attribute__((ext_vector_type(8)));
typedef float f32x4 __attribute__((ext_vector_type(4)));
typedef float f32x2 __attribute__((ext_vector_type(2)));
typedef unsigned u32x4 __attribute__((ext_vector_type(4)));
typedef unsigned u32x2 __attribute__((ext_vector_type(2)));

constexpr int M = 32768, D = 1024, F = 2816, NCHUNK = 256, DEPTH = 2;
constexpr int PW = 4864;
constexpr int C_AU = 0, C_AV = 512, C_BQ = 1024, C_BK = 1536, C_BV = 1664, C_CQ = 1792, C_CK = 2304, C_CV = 2816, C_CG = 3840;
constexpr int C_GT = 1792;
constexpr int C_MG = 2816;
constexpr float NORM_EPS = 1e-6f, GN_EPS = 1e-5f, LOG2E = 1.4426950408889634f;
#ifndef MK_NB
#define MK_NB 1
#endif
constexpr int NB = MK_NB;
constexpr int MH = M / NB, NCH = MH / 128;
constexpr int NPH_LAYER = 5 + 6 * NB, NPHASES = NPH_LAYER * DEPTH + 1;

constexpr size_t MiB = 1u << 20;
constexpr size_t WS_BAR = 0;
constexpr size_t WS_WB = 1 * MiB;
constexpr size_t WS_XB = 57 * MiB;
constexpr size_t WS_P = 121 * MiB;
constexpr size_t WS_KV = WS_P + (size_t)MH * PW * 2;
constexpr size_t WS_G = WS_KV + (size_t)MH * 2048;
constexpr size_t WS_MG = WS_G + (NB == 2 ? 64 * MiB : 0);
constexpr size_t WS_SSP = WS_MG + (NB == 2 ? 64 * MiB : 0);
constexpr size_t WS_END = WS_SSP + 4 * MiB;
static_assert(WS_END <= 512 * MiB && WS_P + (size_t)M * F * 2 <= WS_G, "d_ws map");
constexpr size_t O_W1IN = 0, O_W1OUT = 5767168, O_WIN = 8650752, O_WBA = 16777216, O_WBB = 17301504, O_WBC = 17825792,
                 O_WOUT = 18874368, O_W2IN = 19922944, O_W2OUT = 25690112, O_WS = 28573696, O_WEND = 28639232;
static_assert(O_WEND * 2 <= 56 * MiB, "weights fit");

__device__ __forceinline__ float bflo(unsigned w) { return __uint_as_float(w << 16); }
__device__ __forceinline__ float bfhi(unsigned w) { return __uint_as_float(w & 0xffff0000u); }
__device__ __forceinline__ unsigned f2bf(float f) { unsigned u = __float_as_uint(f); return (u + 0x7fffu + ((u >> 16) & 1u)) >> 16; }
__device__ __forceinline__ unsigned pk2(float lo, float hi) { return f2bf(lo) | (f2bf(hi) << 16); }
__device__ __forceinline__ float fexp2(float x) { return __builtin_amdgcn_exp2f(x); }
__device__ __forceinline__ float frcp(float x) { return __builtin_amdgcn_rcpf(x); }
__device__ __forceinline__ float sigmoid_f(float x) { return frcp(1.0f + fexp2(-x * LOG2E)); }
__device__ __forceinline__ float silu_f(float x) { return x * sigmoid_f(x); }
__device__ __forceinline__ float gelu_tanh_f(float x) { const float u = 0.7978845608028654f * (x + 0.044715f * x * x * x); return x * frcp(1.0f + fexp2(-2.0f * LOG2E * u)); }

__device__ __forceinline__ void st16_wt(void* p, u32x4 v) { asm volatile("global_store_dwordx4 %0, %1, off sc0 sc1" :: "v"(p), "v"(v) : "memory"); }
__device__ __forceinline__ void st8_wt(void* p, u32x2 v) { asm volatile("global_store_dwordx2 %0, %1, off sc0 sc1" :: "v"(p), "v"(v) : "memory"); }
__device__ __forceinline__ void st4_wt(void* p, float v) { asm volatile("global_store_dword %0, %1, off sc0 sc1" :: "v"(p), "v"(v) : "memory"); }
__device__ __forceinline__ float row_rstd(const float* ssp, int row) { const f32x4 p = *(const f32x4*)(ssp + (size_t)row * 4); return rsqrtf(((p[0] + p[1]) + (p[2] + p[3])) * (1.0f / D) + NORM_EPS); }

namespace pg8 {
constexpr int BM = 256, BK = 64, HALF = 128, HTB = HALF * BK * 2, STAGE_BYTES = 8 * HTB, NXCD = 8, WGM = 8;
__host__ __device__ __forceinline__ int lds_byte(int r, int c) { const int st = (r >> 4) * 2 + (c >> 5), rr = r & 15, cc = c & 31, ob = rr * 64 + cc * 2; return st * 1024 + (ob ^ (((ob >> 9) & 1) << 5)); }
__host__ __device__ __forceinline__ void stage_rc(int b, int& R, int& C) { const int st = b / 1024, sb = b % 1024, swz = sb ^ (((sb >> 9) & 1) << 5); R = (st >> 1) * 16 + swz / 64; C = (st & 1) * 32 + (swz % 64) / 2; }
__host__ __device__ __forceinline__ int perm32(int rho) { const int n = rho >> 4, i = rho & 15; return 8 * (i >> 2) + 4 * n + (i & 3); }

struct Unit { int pm, pn; };
struct Gemm { const bf16_t* A; const bf16_t* Bt; int M, N, K, lda; };

struct StaticOrder {
    int nM, nN, nwg, G, c;
    __device__ void init(int M_, int N_, int G_, int c_) { nM = M_ / BM; nN = N_ / BM; nwg = nM * nN; G = G_; c = c_; }
    __device__ bool next(int i, Unit& u) const {
        const long L = (long)i * G + c; if (L >= nwg) return false;
        int wgid = (int)L; { const int q = nwg / NXCD, r = nwg % NXCD, xcd = wgid % NXCD, off = wgid / NXCD; wgid = (xcd < r ? xcd * (q + 1) : r * (q + 1) + (xcd - r) * q) + off; }
        const int nig = WGM * nN, gid = wgid / nig, fm = gid * WGM, gsz = (nM - fm) < WGM ? (nM - fm) : WGM;
        u.pm = fm + ((wgid % nig) % gsz); u.pn = (wgid % nig) / gsz; return true;
    }
};
typedef __bf16 bf16x2_t __attribute__((ext_vector_type(2)));
__device__ __forceinline__ unsigned cvt_pk_bf16(float lo, float hi) { const f32x2 v = {lo, hi}; const bf16x2_t b = __builtin_convertvector(v, bf16x2_t); return __builtin_bit_cast(unsigned, b); }

template <class Epi>
__device__ __forceinline__ void gemm_phase(LAS unsigned char* lds, const Gemm g, const StaticOrder& S, const Epi& E) {
    int tid = threadIdx.x; asm volatile("" : "+v"(tid));
    const int wid = __builtin_amdgcn_readfirstlane(tid >> 6), lane = tid & 63, wr = wid >> 2, wc = wid & 3, fr = lane & 15, fq = lane >> 4;
    const int K = g.K, nt = K / BK, lda = g.lda;
    unsigned voffA[2], voffB[2];
#pragma unroll
    for (int i = 0; i < 2; ++i) { int R, C; stage_rc(tid * 16 + i * 8192, R, C); const int Rb = Epi::PERM ? ((R & ~31) + perm32(R & 31)) : R;
        voffA[i] = (unsigned)(R * lda + C) * 2u; voffB[i] = (unsigned)(Rb * K + C) * 2u; }
    const size_t kstep = (size_t)(BK * 2);
    const size_t hstepA = (size_t)HALF * lda * 2, hstepB = (size_t)HALF * K * 2;
    const size_t tstepA = 2 * hstepA, tstepB = 2 * hstepB;
    const unsigned ldsw = (unsigned)wid * 1024u;
    const int aoff = lds_byte(wr * 64 + fr, fq * 8), boff = lds_byte(wc * 32 + fr, fq * 8);
#define PG8_SA(b, h) (((b) * 2 + (h)) * HTB)
#define PG8_SB(b, h) ((4 + (b) * 2 + (h)) * HTB)
#define PG8_STAGE(bufoff, gbase, voff) do { _Pragma("unroll") for (int _i = 0; _i < 2; ++_i) \
        __builtin_amdgcn_global_load_lds((const unsigned*)((const char*)(gbase) + (voff)[_i]), (LAS unsigned*)(lds + (bufoff) + ldsw + _i * 8192), 16, 0, 0); } while (0)
#define PG8_LDA(dst, b, h) do { _Pragma("unroll") for (int m = 0; m < 4; ++m) _Pragma("unroll") for (int k = 0; k < 2; ++k) dst[m][k] = *(const LAS bf16x8*)(lds + PG8_SA(b, h) + aoff + m * 2048 + k * 1024); } while (0)
#define PG8_LDB(dst, b, h) do { _Pragma("unroll") for (int n = 0; n < 2; ++n) _Pragma("unroll") for (int k = 0; k < 2; ++k) dst[n][k] = *(const LAS bf16x8*)(lds + PG8_SB(b, h) + boff + n * 2048 + k * 1024); } while (0)
#define PG8_MMA(ai, bj, At, Bt) do { __builtin_amdgcn_s_setprio(1); _Pragma("unroll") for (int m = 0; m < 4; ++m) _Pragma("unroll") for (int n = 0; n < 2; ++n) _Pragma("unroll") for (int k = 0; k < 2; ++k) \
        acc[ai][bj][m][n] = __builtin_amdgcn_mfma_f32_16x16x32_bf16(Bt[n][k], At[m][k], acc[ai][bj][m][n], 0, 0, 0); __builtin_amdgcn_s_setprio(0); } while (0)
#define PG8_WAIT_V(n) asm volatile("s_waitcnt vmcnt(" #n ")" ::: "memory")
#define PG8_WAIT_L(n) asm volatile("s_waitcnt lgkmcnt(" #n ")" ::: "memory")
#define PG8_BAR __builtin_amdgcn_s_barrier()
#define PG8_SCHED __builtin_amdgcn_sched_barrier(0)
    Unit cur, nxt; int ui = 0;
    if (!S.next(0, cur)) return;
    f32x4 acc[2][2][4][2];
#pragma unroll
    for (int a = 0; a < 2; ++a)
#pragma unroll
        for (int b = 0; b < 2; ++b)
#pragma unroll
            for (int m = 0; m < 4; ++m)
#pragma unroll
                for (int n = 0; n < 2; ++n) acc[a][b][m][n] = (f32x4){0.f, 0.f, 0.f, 0.f};
    bf16x8 At[4][2], B0[2][2], B1[2][2];
    const char* cA = (const char*)g.A + (size_t)cur.pm * tstepA; const char* cB = (const char*)g.Bt + (size_t)cur.pn * tstepB;
    PG8_STAGE(PG8_SB(0, 0), cB, voffB); PG8_STAGE(PG8_SB(0, 1), cB + hstepB, voffB); PG8_STAGE(PG8_SA(0, 0), cA, voffA); PG8_STAGE(PG8_SA(0, 1), cA + hstepA, voffA);
    if (wr == 1) PG8_BAR;
    PG8_WAIT_V(2); PG8_BAR;
    PG8_STAGE(PG8_SB(1, 0), cB + kstep, voffB); PG8_STAGE(PG8_SA(1, 0), cA + kstep, voffA); PG8_STAGE(PG8_SB(1, 1), cB + hstepB + kstep, voffB);
    PG8_WAIT_V(6); PG8_BAR;
    for (;;) {
        const bool has_next = S.next(ui + 1, nxt);
        const char* nA = has_next ? (const char*)g.A + (size_t)nxt.pm * tstepA : cA; const char* nB = has_next ? (const char*)g.Bt + (size_t)nxt.pn * tstepB : cB;
        for (int t = 0; t < nt; t += 2) {
            const bool last = (t == nt - 2);
            const char* a1 = cA + (size_t)(t + 1) * kstep;
            const char* a2 = last ? nA : cA + (size_t)(t + 2) * kstep; const char* b2 = last ? nB : cB + (size_t)(t + 2) * kstep;
            const char* a3 = a2 + kstep; const char* b3 = b2 + kstep;
            PG8_LDB(B0, 0, 0); PG8_LDB(B1, 0, 1); PG8_SCHED; PG8_LDA(At, 0, 0); PG8_STAGE(PG8_SA(1, 1), a1 + hstepA, voffA);
            PG8_WAIT_V(8); PG8_WAIT_L(0); PG8_BAR; PG8_MMA(0, 0, At, B0); PG8_MMA(0, 1, At, B1); PG8_BAR; PG8_SCHED;
            PG8_LDA(At, 0, 1); PG8_STAGE(PG8_SB(0, 0), b2, voffB); PG8_STAGE(PG8_SB(0, 1), b2 + hstepB, voffB); PG8_STAGE(PG8_SA(0, 0), a2, voffA);
            PG8_WAIT_V(8); PG8_WAIT_L(0); PG8_BAR; PG8_MMA(1, 0, At, B0); PG8_MMA(1, 1, At, B1); PG8_BAR; PG8_SCHED;
            PG8_LDB(B0, 1, 0); PG8_LDB(B1, 1, 1); PG8_SCHED; PG8_LDA(At, 1, 0); PG8_STAGE(PG8_SA(0, 1), a2 + hstepA, voffA);
            PG8_WAIT_V(8); PG8_WAIT_L(0); PG8_BAR; PG8_MMA(0, 0, At, B0); PG8_MMA(0, 1, At, B1); PG8_BAR; PG8_SCHED;
            PG8_LDA(At, 1, 1); PG8_STAGE(PG8_SB(1, 0), b3, voffB); PG8_STAGE(PG8_SB(1, 1), b3 + hstepB, voffB); PG8_STAGE(PG8_SA(1, 0), a3, voffA);
            PG8_WAIT_V(8); PG8_WAIT_L(0); PG8_BAR; PG8_MMA(1, 0, At, B0); PG8_MMA(1, 1, At, B1); PG8_BAR; PG8_SCHED;
        }
        if (wr == 0) PG8_BAR;
        E(acc, cur, wr, wc, fr, fq);
        if (!has_next) break;
#pragma unroll
        for (int a = 0; a < 2; ++a)
#pragma unroll
            for (int b = 0; b < 2; ++b)
#pragma unroll
                for (int m = 0; m < 4; ++m)
#pragma unroll
                    for (int n = 0; n < 2; ++n) acc[a][b][m][n] = (f32x4){0.f, 0.f, 0.f, 0.f};
        cur = nxt; cA = nA; cB = nB; ++ui;
        if (wr == 1) PG8_BAR;
    }
    PG8_WAIT_V(0);
    PG8_BAR;
#undef PG8_SA
#undef PG8_SB
#undef PG8_STAGE
#undef PG8_LDA
#undef PG8_LDB
#undef PG8_MMA
#undef PG8_WAIT_V
#undef PG8_WAIT_L
#undef PG8_BAR
#undef PG8_SCHED
}

struct EpiSwiglu {
    static constexpr bool PERM = true;
    bf16_t* H; const float* ss;
    __device__ __forceinline__ void operator()(const f32x4 (&acc)[2][2][4][2], const Unit& u, int wr, int wc, int fr, int fq) const {
        const int row0 = u.pm * BM + wr * 64 + fr, col0 = u.pn * 128 + wc * 32 + 8 * fq;
#pragma unroll
        for (int ai = 0; ai < 2; ++ai)
#pragma unroll
            for (int m = 0; m < 4; ++m) { const int row = row0 + ai * HALF + m * 16; const float r = row_rstd(ss, row);
                float h[8];
#pragma unroll
                for (int n = 0; n < 2; ++n)
#pragma unroll
                    for (int e = 0; e < 4; ++e) { const float a = acc[ai][0][m][n][e] * r, b = acc[ai][1][m][n][e] * r; h[n * 4 + e] = silu_f(a) * b; }
                u32x4 w; w.x = cvt_pk_bf16(h[0], h[1]); w.y = cvt_pk_bf16(h[2], h[3]); w.z = cvt_pk_bf16(h[4], h[5]); w.w = cvt_pk_bf16(h[6], h[7]);
                *(u32x4*)(H + (size_t)row * F + col0) = w; }
    }
};
struct EpiResid {
    static constexpr bool PERM = true;
    const float* base32; bf16_t* xb; float* ssn; float scale; LAS float* red;
    __device__ __forceinline__ void operator()(const f32x4 (&acc)[2][2][4][2], const Unit& u, int wr, int wc, int fr, int fq) const {
        const int row0 = u.pm * BM + wr * 64 + fr, col0 = u.pn * BM + wc * 32 + 8 * fq;
#pragma unroll
        for (int ai = 0; ai < 2; ++ai)
#pragma unroll
            for (int m = 0; m < 4; ++m) { const int row = row0 + ai * HALF + m * 16; const size_t off = (size_t)row * D + col0; float q = 0.f;
#pragma unroll
                for (int bj = 0; bj < 2; ++bj) { const size_t o2 = off + bj * HALF; f32x4 b0, b1;
                    if (base32) { b0 = *(const f32x4*)(base32 + o2); b1 = *(const f32x4*)(base32 + o2 + 4); }
                    else { const u32x4 bw = *(const u32x4*)(xb + o2); b0 = (f32x4){bflo(bw.x), bfhi(bw.x), bflo(bw.y), bfhi(bw.y)}; b1 = (f32x4){bflo(bw.z), bfhi(bw.z), bflo(bw.w), bfhi(bw.w)}; }
                    const f32x4 o0 = b0 + acc[ai][bj][m][0] * scale, o1 = b1 + acc[ai][bj][m][1] * scale;
                    u32x4 w; w.x = cvt_pk_bf16(o0[0], o0[1]); w.y = cvt_pk_bf16(o0[2], o0[3]); w.z = cvt_pk_bf16(o1[0], o1[1]); w.w = cvt_pk_bf16(o1[2], o1[3]);
                    *(u32x4*)(xb + o2) = w;
                    q += ((o0[0] * o0[0] + o0[1] * o0[1]) + (o0[2] * o0[2] + o0[3] * o0[3])) + ((o1[0] * o1[0] + o1[1] * o1[1]) + (o1[2] * o1[2] + o1[3] * o1[3])); }
                q += __shfl_xor(q, 16); q += __shfl_xor(q, 32);
                if (fq == 0) red[(ai * HALF + wr * 64 + m * 16 + fr) * 4 + wc] = q;
                if ((m & (MK_FENCE - 1)) == MK_FENCE - 1) asm volatile("" ::: "memory"); }
        asm volatile("s_waitcnt lgkmcnt(0)" ::: "memory"); __builtin_amdgcn_s_barrier(); asm volatile("" ::: "memory");
        if (wr == 0) { const int t = wc * 64 + fq * 16 + fr; const f32x4 p = *(const LAS f32x4*)(red + t * 4);
            ssn[((size_t)u.pm * BM + t) * 4 + u.pn] = (p[0] + p[1]) + (p[2] + p[3]); }
    }
};
struct EpiInproj {
    static constexpr bool PERM = true;
    bf16_t* P; const float* ss;
    __device__ __forceinline__ void operator()(const f32x4 (&acc)[2][2][4][2], const Unit& u, int wr, int wc, int fr, int fq) const {
        if (u.pn < 4) run<1>(acc, u, wr, wc, fr, fq); else if (u.pn >= 15) run<2>(acc, u, wr, wc, fr, fq); else run<0>(acc, u, wr, wc, fr, fq);
    }
    template <int ACT> __device__ __forceinline__ void run(const f32x4 (&acc)[2][2][4][2], const Unit& u, int wr, int wc, int fr, int fq) const {
        const int row0 = u.pm * BM + wr * 64 + fr, col0 = u.pn * BM + wc * 32 + 8 * fq;
#pragma unroll
        for (int ai = 0; ai < 2; ++ai)
#pragma unroll
            for (int m = 0; m < 4; ++m) { const int row = row0 + ai * HALF + m * 16; const float r = row_rstd(ss, row);
#pragma unroll
                for (int bj = 0; bj < 2; ++bj) { float h[8];
#pragma unroll
                    for (int n = 0; n < 2; ++n)
#pragma unroll
                        for (int e = 0; e < 4; ++e) { const float v = acc[ai][bj][m][n][e] * r; h[n * 4 + e] = (ACT == 1) ? gelu_tanh_f(v) : ((ACT == 2) ? silu_f(v) : v); }
                    u32x4 w; w.x = cvt_pk_bf16(h[0], h[1]); w.y = cvt_pk_bf16(h[2], h[3]); w.z = cvt_pk_bf16(h[4], h[5]); w.w = cvt_pk_bf16(h[6], h[7]);
#if MK_WTIN
                    asm volatile("global_store_dwordx4 %0, %1, off sc0 sc1" :: "v"(P + (size_t)row * PW + col0 + bj * HALF), "v"(w) : "memory"); } }
#else
                    *(u32x4*)(P + (size_t)row * PW + col0 + bj * HALF) = w; } }
#endif
    }
};
struct EpiGate {
    static constexpr bool PERM = true;
    bf16_t* G; const float* ss; const float* bias; int ld; float* dbg32;
    __device__ __forceinline__ void operator()(const f32x4 (&acc)[2][2][4][2], const Unit& u, int wr, int wc, int fr, int fq) const {
        const int row0 = u.pm * BM + wr * 64 + fr, col0 = u.pn * BM + wc * 32 + 8 * fq;
#pragma unroll
        for (int ai = 0; ai < 2; ++ai)
#pragma unroll
            for (int m = 0; m < 4; ++m) { const int row = row0 + ai * HALF + m * 16; const float r = row_rstd(ss, row);
#pragma unroll
                for (int bj = 0; bj < 2; ++bj) { float h[8]; const f32x4 b0 = *(const f32x4*)(bias + col0 + bj * HALF), b1 = *(const f32x4*)(bias + col0 + bj * HALF + 4);
#pragma unroll
#ifdef MK_X1
                    for (int e = 0; e < 4; ++e) { h[e] = sigmoid_f(acc[ai][bj][m][0][e] * 0.03f + 0.f * (r + b0[e])); h[4 + e] = sigmoid_f(acc[ai][bj][m][1][e] * 0.03f + 0.f * b1[e]); }
#else
                    for (int e = 0; e < 4; ++e) { h[e] = sigmoid_f(acc[ai][bj][m][0][e] * r + b0[e]); h[4 + e] = sigmoid_f(acc[ai][bj][m][1][e] * r + b1[e]); }
#endif
                    u32x4 w; w.x = cvt_pk_bf16(h[0], h[1]); w.y = cvt_pk_bf16(h[2], h[3]); w.z = cvt_pk_bf16(h[4], h[5]); w.w = cvt_pk_bf16(h[6], h[7]);
#if MK_WTG
                    asm volatile("global_store_dwordx4 %0, %1, off sc0 sc1" :: "v"(G + (size_t)row * ld + col0 + bj * HALF), "v"(w) : "memory");
#else
                    *(u32x4*)(G + (size_t)row * ld + col0 + bj * HALF) = w;
#endif
                    if (dbg32) { *(f32x4*)(dbg32 + (size_t)row * D + col0 + bj * HALF) = (f32x4){h[0], h[1], h[2], h[3]}; *(f32x4*)(dbg32 + (size_t)row * D + col0 + bj * HALF + 4) = (f32x4){h[4], h[5], h[6], h[7]}; } }
                if ((m & (MK_FENCE - 1)) == MK_FENCE - 1) asm volatile("" ::: "memory"); }
    }
};
struct EpiMerge {
    static constexpr bool PERM = true;
    const bf16_t* G; bf16_t* Mg; int first, ld;
    __device__ __forceinline__ void operator()(const f32x4 (&acc)[2][2][4][2], const Unit& u, int wr, int wc, int fr, int fq) const {
        const int row0 = u.pm * BM + wr * 64 + fr, col0 = u.pn * BM + wc * 32 + 8 * fq;
#pragma unroll
        for (int ai = 0; ai < 2; ++ai)
#pragma unroll
            for (int m = 0; m < 4; ++m) { const int row = row0 + ai * HALF + m * 16;
#pragma unroll
                for (int bj = 0; bj < 2; ++bj) { const size_t off = (size_t)row * ld + col0 + bj * HALF;
                    const u32x4 gv = *(const u32x4*)(G + off); u32x4 mv = (u32x4){0u, 0u, 0u, 0u}; if (!first) mv = *(const u32x4*)(Mg + off);
                    float h[8];
#pragma unroll
                    for (int n = 0; n < 2; ++n) { const unsigned g0 = n ? gv.z : gv.x, g1 = n ? gv.w : gv.y, m0 = n ? mv.z : mv.x, m1 = n ? mv.w : mv.y;
                        h[n * 4 + 0] = bflo(m0) + bflo(g0) * acc[ai][bj][m][n][0]; h[n * 4 + 1] = bfhi(m0) + bfhi(g0) * acc[ai][bj][m][n][1];
                        h[n * 4 + 2] = bflo(m1) + bflo(g1) * acc[ai][bj][m][n][2]; h[n * 4 + 3] = bfhi(m1) + bfhi(g1) * acc[ai][bj][m][n][3]; }
                    u32x4 w; w.x = cvt_pk_bf16(h[0], h[1]); w.y = cvt_pk_bf16(h[2], h[3]); w.z = cvt_pk_bf16(h[4], h[5]); w.w = cvt_pk_bf16(h[6], h[7]);
                    *(u32x4*)(Mg + off) = w; }
                if ((m & (MK_FENCE - 1)) == MK_FENCE - 1) asm volatile("" ::: "memory"); }
    }
};
}

template <int KSTEPS>
__device__ __forceinline__ f32x4 mma_k(const LAS unsigned char* pa, const LAS unsigned char* pb, f32x4 acc) {
#pragma unroll
    for (int s = 0; s < KSTEPS; ++s) { const bf16x8 a = *(const LAS bf16x8*)(pa + s * 64); const bf16x8 b = *(const LAS bf16x8*)(pb + s * 64);
        acc = __builtin_amdgcn_mfma_f32_16x16x32_bf16(a, b, acc, 0, 0, 0); }
    return acc;
}
typedef short v4i16 __attribute__((ext_vector_type(4)));
__device__ __forceinline__ bf16x8 ld_tr_frag(const LAS unsigned char* img, int pitch, int tok0, int ch0, int lane) {
    const int g = lane >> 4, q = (lane & 15) >> 2, p = lane & 3;
    const LAS unsigned char* a = img + (tok0 + 8 * g + q) * pitch + (ch0 + 4 * p) * 2;
    const v4i16 lo = __builtin_amdgcn_ds_read_tr16_b64_v4i16((LAS v4i16*)a);
    const v4i16 hi = __builtin_amdgcn_ds_read_tr16_b64_v4i16((LAS v4i16*)(a + 4 * pitch));
    return __builtin_shufflevector(lo, hi, 0, 1, 2, 3, 4, 5, 6, 7);
}
__device__ __forceinline__ void lds_st16(LAS unsigned char* p, unsigned v) { *(LAS unsigned short*)p = (unsigned short)v; }

__device__ __forceinline__ void unit_gmlp(LAS unsigned char* L, bf16_t* P, const bf16_t* WSb, const float* vnorm, const float* bs, int ci, int tid) {
    asm volatile("" : "+v"(tid));
    const int lane = tid & 63, wid = tid >> 6, l15 = lane & 15, lq = lane >> 4;
    constexpr int PT = 272;
    LAS unsigned char* Wl = L; LAS unsigned char* VT = L + 34816; LAS float* rs = (LAS float*)(L + 69632);
    bf16_t* Prow = P + (size_t)ci * 128 * PW;
    {
        const int t = tid >> 2, part = tid & 3; const bf16_t* src = Prow + (size_t)t * PW + C_AV + part * 128; float s = 0.f;
#pragma unroll 4
        for (int i = 0; i < 16; ++i) { const u32x4 v = *((const u32x4*)(src + 8 * i));
            s += bflo(v.x) * bflo(v.x) + bfhi(v.x) * bfhi(v.x) + bflo(v.y) * bflo(v.y) + bfhi(v.y) * bfhi(v.y) + bflo(v.z) * bflo(v.z) + bfhi(v.z) * bfhi(v.z) + bflo(v.w) * bflo(v.w) + bfhi(v.w) * bfhi(v.w); }
        s += __shfl_xor(s, 1); s += __shfl_xor(s, 2);
        if (part == 0) rs[t] = rsqrtf(s * (1.0f / 512.0f) + NORM_EPS);
    }
    __syncthreads();
    for (int g = 0; g < 4; ++g) {
        for (int i = tid; i < 2048; i += 512) { const int r = i >> 4, c = i & 15; *(LAS u32x4*)(Wl + r * PT + c * 16) = *((const u32x4*)(WSb + g * 16384 + r * 128 + c * 8)); }
        for (int i = tid; i < 2048; i += 512) { const int r = i >> 4, c = i & 15; const float rr = rs[r]; const float* gn = vnorm + g * 128 + c * 8;
            const u32x4 v = *((const u32x4*)(Prow + (size_t)r * PW + C_AV + g * 128 + c * 8)); const f32x4 g0 = *(const f32x4*)gn, g1 = *(const f32x4*)(gn + 4);
            u32x4 o; o.x = pk2(bflo(v.x) * rr * g0[0], bfhi(v.x) * rr * g0[1]); o.y = pk2(bflo(v.y) * rr * g0[2], bfhi(v.y) * rr * g0[3]);
            o.z = pk2(bflo(v.z) * rr * g1[0], bfhi(v.z) * rr * g1[1]); o.w = pk2(bflo(v.w) * rr * g1[2], bfhi(v.w) * rr * g1[3]);
            *(LAS u32x4*)(VT + r * PT + c * 16) = o; }
        __syncthreads();
        {   bf16x8 af[4];
#pragma unroll
            for (int s = 0; s < 4; ++s) af[s] = ld_tr_frag(VT, PT, 32 * s, 16 * wid, lane);
#pragma unroll
            for (int tt = 0; tt < 8; ++tt) { const LAS unsigned char* pb = Wl + (16 * tt + l15) * PT + lq * 16;
                f32x4 acc = (f32x4){0.f, 0.f, 0.f, 0.f};
#pragma unroll
                for (int s = 0; s < 4; ++s) acc = __builtin_amdgcn_mfma_f32_16x16x32_bf16(af[s], *(const LAS bf16x8*)(pb + s * 64), acc, 0, 0, 0);
                const int t = 16 * tt + l15, d = 16 * wid + 4 * lq; const float b = bs[g * 128 + t];
                bf16_t* up = Prow + (size_t)t * PW + C_AU + g * 128 + d; const u32x2 uv = *((const u32x2*)up);
                u32x2 o; o.x = pk2(bflo(uv.x) * (acc[0] + b), bfhi(uv.x) * (acc[1] + b)); o.y = pk2(bflo(uv.y) * (acc[2] + b), bfhi(uv.y) * (acc[3] + b));
                *(u32x2*)up = o; }
        }
        __syncthreads();
    }
}

__device__ __forceinline__ void unit_attn(LAS unsigned char* L, bf16_t* P, const float* sinks, int ci, int tid) {
    asm volatile("" : "+v"(tid));
    const int lane = tid & 63, wid = tid >> 6, l15 = lane & 15, lq = lane >> 4;
    constexpr int PK = 144, PV = 144, PP = 336;
    LAS unsigned char* Kl = L; LAS unsigned char* VT = L + 36864; LAS unsigned char* Pl = L + 73728 + wid * 5376;
    const int n = ci & 127; const long rowbase = (long)ci * 128 - 128;
    for (int kvh = 0; kvh < 2; ++kvh) {
        for (int i = tid; i < 2048; i += 512) { const int r = i >> 3, c = i & 7; u32x4 v = (u32x4){0u, 0u, 0u, 0u};
            if (n > 0 || r >= 128) v = *((const u32x4*)(P + (size_t)(rowbase + r) * PW + C_BK + kvh * 64 + c * 8));
            *(LAS u32x4*)(Kl + r * PK + c * 16) = v; }
        for (int i = tid; i < 2048; i += 512) { const int r = i >> 3, c = i & 7; u32x4 v = (u32x4){0u, 0u, 0u, 0u};
            if (n > 0 || r >= 128) v = *(const u32x4*)(P + (size_t)(rowbase + r) * PW + C_BV + kvh * 64 + c * 8);
            *(LAS u32x4*)(VT + r * PV + c * 16) = v; }
        __syncthreads();
        const bf16_t* qq0 = P + ((size_t)ci * 128 + 16 * ((wid & 1) * 4) + l15) * PW + C_BQ + (kvh * 4 + (wid >> 1)) * 64 + lq * 8;
        bf16x8 qn0 = *(const bf16x8*)qq0, qn1 = *(const bf16x8*)(qq0 + 32);
        for (int it = 0; it < 4; ++it) {
            const bf16x8 q0 = qn0, q1 = qn1;
            if (it < 3) { const bf16_t* qq = qq0 + (size_t)(16 * (it + 1)) * PW; qn0 = *(const bf16x8*)qq; qn1 = *(const bf16x8*)(qq + 32); }
            const int g = wid >> 1, qt = (wid & 1) * 4 + it, h = kvh * 4 + g;
            const float slope = fexp2(-(float)(h + 1)), sink = sinks[h];
            const size_t qrow = (size_t)ci * 128 + 16 * qt + l15;
            bf16_t* qp = P + qrow * PW + C_BQ + h * 64;
            const int kt0 = qt & ~1;
            f32x4 sc[10];
#pragma unroll
            for (int i = 0; i < 10; ++i) { const LAS unsigned char* pa = Kl + (16 * (kt0 + i) + l15) * PK + lq * 16;
                f32x4 a = __builtin_amdgcn_mfma_f32_16x16x32_bf16(*(const LAS bf16x8*)pa, q0, (f32x4){0.f, 0.f, 0.f, 0.f}, 0, 0, 0);
                sc[i] = __builtin_amdgcn_mfma_f32_16x16x32_bf16(*(const LAS bf16x8*)(pa + 64), q1, a, 0, 0, 0); }
            const int qpos = 128 + 16 * qt + l15; float mx = sink;
#pragma unroll
            for (int i = 0; i < 10; ++i)
#pragma unroll
                for (int j = 0; j < 4; ++j) { const int kpos = 16 * (kt0 + i) + 4 * lq + j, dist = qpos - kpos; const bool valid = dist >= 0 && dist < 128 && (n > 0 || kpos >= 128);
                    const float s = valid ? sc[i][j] * 0.125f - slope * (float)dist : -INFINITY; sc[i][j] = s; mx = fmaxf(mx, s); }
            mx = fmaxf(mx, __shfl_xor(mx, 16)); mx = fmaxf(mx, __shfl_xor(mx, 32));
            float sum = 0.f;
#pragma unroll
            for (int i = 0; i < 10; ++i)
#pragma unroll
                for (int j = 0; j < 4; ++j) { const float p = fexp2((sc[i][j] - mx) * LOG2E); sc[i][j] = p; sum += p; }
            sum += __shfl_xor(sum, 16); sum += __shfl_xor(sum, 32);
            sum += fexp2((sink - mx) * LOG2E);
            const float inv = 1.0f / sum;
#pragma unroll
            for (int i = 0; i < 10; ++i) { u32x2 w; w.x = pk2(sc[i][0] * inv, sc[i][1] * inv); w.y = pk2(sc[i][2] * inv, sc[i][3] * inv);
                *(LAS u32x2*)(Pl + l15 * PP + (16 * i + 4 * lq) * 2) = w; }
            asm volatile("s_waitcnt lgkmcnt(0)" ::: "memory");
#pragma unroll
            for (int dt = 0; dt < 4; ++dt) { f32x4 acc = (f32x4){0.f, 0.f, 0.f, 0.f};
#pragma unroll
                for (int s5 = 0; s5 < 5; ++s5) { const bf16x8 a = ld_tr_frag(VT, PV, 16 * kt0 + 32 * s5, 16 * dt, lane);
                    const bf16x8 b = *(const LAS bf16x8*)(Pl + l15 * PP + (32 * s5 + 8 * lq) * 2);
                    acc = __builtin_amdgcn_mfma_f32_16x16x32_bf16(a, b, acc, 0, 0, 0); }
                u32x2 o; o.x = pk2(acc[0], acc[1]); o.y = pk2(acc[2], acc[3]);
                *(u32x2*)(qp + 16 * dt + 4 * lq) = o; }
            asm volatile("s_waitcnt lgkmcnt(0)" ::: "memory");
        }
        __syncthreads();
    }
}

struct KvRegs { u32x4 v[8], k[4]; };
__device__ __forceinline__ void kv_load(KvRegs& R, const bf16_t* P, int u, int tid) {
    const int ci = u >> 2, h = u & 3; const bf16_t* Pr = P + (size_t)ci * 128 * PW;
#pragma unroll
    for (int j = 0; j < 8; ++j) { const int i = tid + 512 * j, r = i >> 5, c = i & 31; R.v[j] = *((const u32x4*)(Pr + (size_t)r * PW + C_CV + h * 256 + c * 8)); }
#pragma unroll
    for (int j = 0; j < 4; ++j) { const int i = tid + 512 * j, r = i >> 4, c = i & 15; R.k[j] = *((const u32x4*)(Pr + (size_t)r * PW + C_CK + h * 128 + c * 8)); }
}
__device__ __forceinline__ void kv_store(LAS unsigned char* L, const KvRegs& R, int u, int tid) {
    constexpr int PVI = 528, PKI = 272; LAS unsigned char* Vi = L; LAS unsigned char* Ki = L + 128 * PVI;
    const float lg = log2f(1.0f - exp2f(-5.0f - (float)(u & 3)));
#pragma unroll
    for (int j = 0; j < 8; ++j) { const int i = tid + 512 * j, r = i >> 5, c = i & 31; *(LAS u32x4*)(Vi + r * PVI + c * 16) = R.v[j]; }
#pragma unroll
    for (int j = 0; j < 4; ++j) { const int i = tid + 512 * j, r = i >> 4, c = i & 15; const float kw = 0.08838834764831845f * fexp2(lg * (float)(127 - r)); const u32x4 v = R.k[j];
        u32x4 o; o.x = pk2(bflo(v.x) * kw, bfhi(v.x) * kw); o.y = pk2(bflo(v.y) * kw, bfhi(v.y) * kw); o.z = pk2(bflo(v.z) * kw, bfhi(v.z) * kw); o.w = pk2(bflo(v.w) * kw, bfhi(v.w) * kw);
        *(LAS u32x4*)(Ki + r * PKI + c * 16) = o; }
}
__device__ __forceinline__ void kv_compute(LAS unsigned char* L, bf16_t* KV, int u, int tid) {
    const int lane = tid & 63, wid = tid >> 6, l15 = lane & 15, lq = lane >> 4;
    constexpr int PVI = 528, PKI = 272; const LAS unsigned char* Vi = L; const LAS unsigned char* Ki = L + 128 * PVI;
    bf16_t* out = KV + (size_t)u * 32768;
    bf16x8 bfr[2][4];
#pragma unroll
    for (int ee = 0; ee < 2; ++ee)
#pragma unroll
        for (int s = 0; s < 4; ++s) bfr[ee][s] = ld_tr_frag(Vi, PVI, 32 * s, 16 * (2 * wid + ee), lane);
#pragma unroll 2
    for (int dt = 0; dt < 8; ++dt) { bf16x8 af[4];
#pragma unroll
        for (int s = 0; s < 4; ++s) af[s] = ld_tr_frag(Ki, PKI, 32 * s, 16 * dt, lane);
#pragma unroll
        for (int ee = 0; ee < 2; ++ee) { f32x4 acc = (f32x4){0.f, 0.f, 0.f, 0.f};
#pragma unroll
            for (int s = 0; s < 4; ++s) acc = __builtin_amdgcn_mfma_f32_16x16x32_bf16(af[s], bfr[ee][s], acc, 0, 0, 0);
            u32x2 o; o.x = pk2(acc[0], acc[1]); o.y = pk2(acc[2], acc[3]);
            *(u32x2*)(out + (16 * (2 * wid + ee) + l15) * 128 + 16 * dt + 4 * lq) = o; } }
}

__device__ __forceinline__ void phase_scan(bf16_t* KV, int gtid, int gthreads) {
    for (int w = gtid; w < 65536 * (MH / 16384); w += gthreads) {
        const int b = w >> 16, h = (w >> 14) & 3, e2 = w & 16383;
        const float decay = exp2f(128.0f * log2f(1.0f - exp2f(-5.0f - (float)h)));
        float st0 = 0.f, st1 = 0.f;
        unsigned* base = (unsigned*)(KV + ((size_t)(b * 128) * 4 + h) * 32768) + e2;
        for (int n0 = 0; n0 < 128; n0 += 16) {
            unsigned v[16];
#pragma unroll
            for (int i = 0; i < 16; ++i) v[i] = *(base + (size_t)(n0 + i) * 4 * 16384);
#pragma unroll
            for (int i = 0; i < 16; ++i) { base[(size_t)(n0 + i) * 4 * 16384] = pk2(st0, st1);
                st0 = decay * st0 + bflo(v[i]); st1 = decay * st1 + bfhi(v[i]); }
        }
    }
}

struct RetRegs { u32x4 q[4], k[4]; };
__device__ __forceinline__ void ret_load(RetRegs& R, const bf16_t* P, int u, int tid) {
    const int ci = u >> 2, h = u & 3;
#pragma unroll
    for (int j = 0; j < 4; ++j) { const int i = tid + 512 * j, r = i >> 4, c = i & 15; const bf16_t* src = P + ((size_t)ci * 128 + r) * PW + h * 128 + c * 8;
        R.q[j] = *((const u32x4*)(src + C_CQ)); R.k[j] = *((const u32x4*)(src + C_CK)); }
}
__device__ __forceinline__ void unit_ret(LAS unsigned char* L, bf16_t* P, const bf16_t* KV, const float* gn, int u, int tid, RetRegs& RR, int u_next) {
    asm volatile("" : "+v"(tid));
    const int lane = tid & 63, wid = tid >> 6, l15 = lane & 15, lq = lane >> 4;
    constexpr int PT = 272, R = 34816;
    LAS unsigned char* Ql = L; LAS unsigned char* Kl = L + R; LAS unsigned char* Pl = L + 2 * R; LAS unsigned char* Sl = L + 3 * R;
    const int ci = u >> 2, h = u & 3; const size_t row0 = (size_t)ci * 128;
    const float lg = log2f(1.0f - exp2f(-5.0f - (float)h));
#pragma unroll
    for (int j = 0; j < 4; ++j) { const int i = tid + 512 * j, r = i >> 4, c = i & 15; *(LAS u32x4*)(Ql + r * PT + c * 16) = RR.q[j]; *(LAS u32x4*)(Kl + r * PT + c * 16) = RR.k[j]; }
    __syncthreads();
    const int t = 16 * wid + l15;
    u32x4 pv[4], ps[4];
#pragma unroll
    for (int j = 0; j < 4; ++j) { const int i = tid + 512 * j, r = i >> 4, c = i & 15;
        pv[j] = *((const u32x4*)(P + (row0 + r) * PW + C_CV + h * 256 + c * 8));
        ps[j] = *((const u32x4*)(KV + (size_t)u * 32768 + r * 128 + c * 8)); }
    {   const LAS unsigned char* pb = Ql + t * PT + lq * 16;
        for (int st = 0; st < 8; ++st) { f32x4 acc = (f32x4){0.f, 0.f, 0.f, 0.f};
            if (st <= wid) { const LAS unsigned char* pa = Kl + (16 * st + l15) * PT + lq * 16; acc = mma_k<4>(pa, pb, acc); }
            float v[4];
#pragma unroll
            for (int j = 0; j < 4; ++j) { const int s = 16 * st + 4 * lq + j; v[j] = (s <= t) ? acc[j] * 0.08838834764831845f * fexp2(lg * (float)(t - s)) : 0.f; }
            u32x2 w; w.x = pk2(v[0], v[1]); w.y = pk2(v[2], v[3]);
            *(LAS u32x2*)(Pl + t * PT + (16 * st + 4 * lq) * 2) = w; }
    }
    __syncthreads();
    f32x4 o[16];
    const float qw = fexp2(lg * (float)(t + 1));
#pragma unroll
    for (int hf = 0; hf < 2; ++hf) {
#pragma unroll
        for (int j = 0; j < 4; ++j) { const int i = tid + 512 * j, r = i >> 4, c = i & 15;
            *(LAS u32x4*)(Kl + r * PT + c * 16) = pv[j]; *(LAS u32x4*)(Sl + r * PT + c * 16) = ps[j]; }
        __syncthreads();
        if (hf == 0) {
#pragma unroll
            for (int j = 0; j < 4; ++j) { const int i = tid + 512 * j, r = i >> 4, c = i & 15;
                pv[j] = *((const u32x4*)(P + (row0 + r) * PW + C_CV + h * 256 + 128 + c * 8));
                ps[j] = *((const u32x4*)(KV + (size_t)u * 32768 + (128 + r) * 128 + c * 8)); } }
        const LAS unsigned char* pbP = Pl + t * PT + lq * 16; const LAS unsigned char* pbQ = Ql + t * PT + lq * 16;
#pragma unroll
        for (int et = 0; et < 8; ++et) { const LAS unsigned char* paS = Sl + (16 * et + l15) * PT + lq * 16;
            f32x4 ai = (f32x4){0.f, 0.f, 0.f, 0.f};
#pragma unroll
            for (int s = 0; s < 4; ++s) ai = __builtin_amdgcn_mfma_f32_16x16x32_bf16(ld_tr_frag(Kl, PT, 32 * s, 16 * et, lane), *(const LAS bf16x8*)(pbP + s * 64), ai, 0, 0, 0);
            const f32x4 ac = mma_k<4>(paS, pbQ, (f32x4){0.f, 0.f, 0.f, 0.f});
            o[hf * 8 + et] = ai + ac * qw; }
        __syncthreads();
    }
    if (u_next >= 0) ret_load(RR, P, u_next, tid);
    float sum = 0.f;
#pragma unroll
    for (int i = 0; i < 16; ++i) sum += (o[i][0] + o[i][1]) + (o[i][2] + o[i][3]);
    sum += __shfl_xor(sum, 16); sum += __shfl_xor(sum, 32);
    const float mean = sum * (1.0f / 256.0f); float var = 0.f;
#pragma unroll
    for (int i = 0; i < 16; ++i) { const f32x4 dd = o[i] - mean; var += (dd[0] * dd[0] + dd[1] * dd[1]) + (dd[2] * dd[2] + dd[3] * dd[3]); }
    var += __shfl_xor(var, 16); var += __shfl_xor(var, 32);
    const float rstd = rsqrtf(var * (1.0f / 256.0f) + GN_EPS);
#pragma unroll
    for (int i = 0; i < 16; ++i) { const int e = 16 * i + 4 * lq; bf16_t* gp = P + (row0 + t) * PW + C_CG + h * 256 + e; const u32x2 gv = *((const u32x2*)gp); const f32x4 gg = *(const f32x4*)(gn + h * 256 + e);
        u32x2 w; w.x = pk2((o[i][0] - mean) * rstd * gg[0] * bflo(gv.x), (o[i][1] - mean) * rstd * gg[1] * bfhi(gv.x));
        w.y = pk2((o[i][2] - mean) * rstd * gg[2] * bflo(gv.y), (o[i][3] - mean) * rstd * gg[3] * bfhi(gv.y));
        *(u32x2*)gp = w; if ((i & 7) == 7) asm volatile("" ::: "memory"); }
    __syncthreads();
}

__device__ __forceinline__ void transpose_item(const float* W, int K, int N, bf16_t* WT, const float* gk, bool swiglu, LAS float* scr, int item, int lane) {
    const int nblk = N / 64, kb = item / nblk, nb = item % nblk, k0 = 64 * kb, n0 = 64 * nb;
    const int kr = lane >> 4, nq = 4 * (lane & 15);
    f32x4 v[16];
#pragma unroll
    for (int i = 0; i < 16; ++i) v[i] = *(const f32x4*)(W + (size_t)(k0 + 4 * i + kr) * N + n0 + nq);
#pragma unroll
    for (int i = 0; i < 16; ++i) { const int kk = 4 * i + kr; const float g = gk ? gk[k0 + kk] : 1.0f; LAS float* d = scr + kk * 65 + nq;
        d[0] = v[i][0] * g; d[1] = v[i][1] * g; d[2] = v[i][2] * g; d[3] = v[i][3] * g; }
    asm volatile("s_waitcnt lgkmcnt(0)" ::: "memory");
    int d0 = n0; if (swiglu) { const int bj = n0 / F, rem = n0 % F; d0 = 256 * (rem / 128) + 128 * bj + (rem % 128); }
    const int c = lane & 7;
#pragma unroll
    for (int j = 0; j < 8; ++j) { const int n = (lane >> 3) + 8 * j; const LAS float* s = scr + (8 * c) * 65 + n;
        u32x4 o; o.x = pk2(s[0 * 65], s[1 * 65]); o.y = pk2(s[2 * 65], s[3 * 65]); o.z = pk2(s[4 * 65], s[5 * 65]); o.w = pk2(s[6 * 65], s[7 * 65]);
        *(u32x4*)(WT + (size_t)(d0 + n) * K + k0 + 8 * c) = o; }
    asm volatile("s_waitcnt lgkmcnt(0)" ::: "memory");
}

#define XB_TMO      128
#define XB_XCNT(j)  (256  + 64 * (j))
#define XB_XSUB(j)  (1280 + 64 * (j))
#define XB_XGEN(j)  (2304 + 64 * (j))
#define XB_TOP      3328
#define XB_TOPGEN   3392
#define XCD_BAR_WORDS 3456
#define XB_SPIN_CAP (1u << 18)
__device__ __forceinline__ unsigned xb_ld(unsigned* p)              { return __hip_atomic_load(p, __ATOMIC_RELAXED, __HIP_MEMORY_SCOPE_AGENT); }
__device__ __forceinline__ unsigned xb_add(unsigned* p, unsigned v) { return __hip_atomic_fetch_add(p, v, __ATOMIC_RELAXED, __HIP_MEMORY_SCOPE_AGENT); }
__device__ __forceinline__ unsigned xb_xcc_id() { return (unsigned)__builtin_amdgcn_s_getreg((3 << 11) | 20) & 0xFu; }
#define XB_SPIN(cond, bar) do { unsigned _sp = 0; while (cond) { __builtin_amdgcn_s_sleep(1); \
    if ((++_sp & 255u) == 0u) { if (xb_ld(&(bar)[XB_TMO])) break; if (_sp > XB_SPIN_CAP) { atomicAdd(&(bar)[XB_TMO], 1u); break; } } } } while (0)
struct XcdBarrier { unsigned* bar; unsigned x; volatile LAS unsigned* st; };
__device__ __forceinline__ XcdBarrier xcd_barrier_post(unsigned* bar, volatile LAS unsigned* st) {
    XcdBarrier b; b.bar = bar; b.x = xb_xcc_id(); b.st = st;
    if (threadIdx.x == 0) (void)xb_add(&bar[XB_XCNT(b.x)], 1u);
    return b;
}
__device__ __forceinline__ void xcd_barrier_complete(unsigned* bar, unsigned x, unsigned& nloc, unsigned& nx) {
    const unsigned G = gridDim.x * gridDim.y * gridDim.z;
    unsigned sum, cnt, mine, sp = 0u;
    for (;;) {
        sum = 0u; cnt = 0u; mine = 0u;
#pragma unroll
        for (unsigned j = 0; j < 16; ++j) { const unsigned c = xb_ld(&bar[XB_XCNT(j)]); sum += c; cnt += (c > 0u) ? 1u : 0u; mine = (j == x) ? c : mine; }
        if (sum == G) break;
        __builtin_amdgcn_s_sleep(1);
        if ((++sp & 255u) == 0u) { if (xb_ld(&bar[XB_TMO])) break; if (sp > XB_SPIN_CAP) { atomicAdd(&bar[XB_TMO], 1u); break; } }
    }
    nloc = mine > 0u ? mine : 1u; nx = cnt > 0u ? cnt : 1u;
}
__device__ __forceinline__ void xcd_barrier(const XcdBarrier& b) {
    asm volatile("s_waitcnt vmcnt(0)" ::: "memory");
    __syncthreads();
    if (threadIdx.x == 0) {
        unsigned* bar = b.bar;
        __builtin_amdgcn_s_waitcnt(0);
        unsigned nloc = b.st[0], nx = b.st[1];
        if (nloc == 0u) { xcd_barrier_complete(bar, b.x, nloc, nx); b.st[0] = nloc; b.st[1] = nx; }
        const unsigned old = xb_add(&bar[XB_XSUB(b.x)], 1u);
        const unsigned gen = old / nloc;
        if (old + 1u == (gen + 1u) * nloc) {
            __builtin_amdgcn_fence(__ATOMIC_RELEASE, "agent");
            asm volatile("s_waitcnt vmcnt(0)" ::: "memory");
            const unsigned og = xb_add(&bar[XB_TOP], 1u);
            const unsigned tg = og / nx;
            if (og + 1u == (tg + 1u) * nx) xb_add(&bar[XB_TOPGEN], 1u);
            else XB_SPIN(xb_ld(&bar[XB_TOPGEN]) == tg, bar);
            __builtin_amdgcn_fence(__ATOMIC_ACQUIRE, "agent");
            xb_add(&bar[XB_XGEN(b.x)], 1u);
            asm volatile("s_waitcnt vmcnt(0)" ::: "memory");
        } else {
            XB_SPIN(xb_ld(&bar[XB_XGEN(b.x)]) == gen, bar);
            __builtin_amdgcn_fence(__ATOMIC_ACQUIRE, "agent");
            asm volatile("s_waitcnt vmcnt(0)" ::: "memory");
        }
    }
    __syncthreads();
}

struct Args { const float* in[20]; float* out; unsigned char* ws; int ph_lo, ph_hi; };

constexpr int LDS_BYTES = 147456;

__global__ void __launch_bounds__(512, 2) mk_fwd(Args a) {
    extern __shared__ __attribute__((aligned(16))) unsigned char lds_raw[];
    LAS unsigned char* L = (LAS unsigned char*)lds_raw;
    volatile LAS unsigned* xst = (volatile LAS unsigned*)(L + 131072 + 8192);
    if (threadIdx.x == 0) { xst[0] = 0u; xst[1] = 0u; }
    __syncthreads();
    const XcdBarrier xbar = xcd_barrier_post((unsigned*)(a.ws + WS_BAR), xst);
#ifndef MK_STOP
#define MK_STOP NPHASES
#endif
    for (int pidx = a.ph_lo; pidx < a.ph_hi; ++pidx) {
        const int ph = (MK_REPBLK) ? ((pidx > 6) ? pidx - 4 : pidx) : (MK_REPPH >= 0) ? ((pidx > MK_REPPH) ? pidx - 1 : pidx) : ((!MK_MULTI && MK_STOP < NPHASES && pidx == a.ph_hi - 1) ? NPHASES - 1 : pidx);
        int tid = threadIdx.x; asm volatile("" : "+v"(tid));
        int bid = blockIdx.x; asm volatile("" : "+s"(bid));
        unsigned char* ws = a.ws; asm volatile("" : "+s"(ws));
        const int lane = tid & 63, wave = __builtin_amdgcn_readfirstlane(tid >> 6);
        const int G = gridDim.x;
        float* SS = (float*)(ws + WS_SSP);
        bf16_t* WB = (bf16_t*)(ws + WS_WB);
        bf16_t* XB = (bf16_t*)(ws + WS_XB);
        bf16_t* KV = (bf16_t*)(ws + WS_KV);
        bf16_t* P = (bf16_t*)(ws + WS_P);
        bf16_t* H = P;
        float* OUT = a.out;
        const int l = ph / NPH_LAYER, k0 = (ph == NPHASES - 1) ? 99 : ph % NPH_LAYER;
        const bool inmix = (k0 >= 3 && k0 < 3 + 6 * NB);
        const int bsel = inmix ? (k0 - 3) / 6 : 0;
        const int k = inmix ? 3 + (k0 - 3) % 6 : (k0 == 3 + 6 * NB ? 15 : (k0 == 4 + 6 * NB ? 16 : k0));
        const size_t rowoff = (size_t)bsel * MH;
#if MK_GOVL || MK_NB == 1
        bf16_t* Gt = P + C_GT; bf16_t* Mg = P + C_MG; const int ldg = PW;
#else
        bf16_t* Gt = (bf16_t*)(ws + WS_G) + rowoff * D; bf16_t* Mg = (bf16_t*)(ws + WS_MG) + rowoff * D; const int ldg = D;
#endif
        if (k == 0) {
            int lane_o = lane; asm volatile("" : "+v"(lane_o));
            LAS float* scr = (LAS float*)(L + wave * 16640);
            const int gw = bid * 8 + wave, NGW = G * 8;
            for (int it = gw; it < 6976; it += NGW) {
                int r = it; const float* W; const float* gk = nullptr; bf16_t* WT; int K_, N_; bool sw = false;
                if (r < 1408) { W = a.in[2] + (size_t)l * D * 2 * F; K_ = D; N_ = 2 * F; WT = WB + O_W1IN; gk = a.in[1] + l * D; sw = true; }
                else if ((r -= 1408) < 704) { W = a.in[3] + (size_t)l * F * D; K_ = F; N_ = D; WT = WB + O_W1OUT; }
                else if ((r -= 704) < 1984) { W = a.in[5] + (size_t)l * D * 7936; K_ = D; N_ = 7936; WT = WB + O_WIN; gk = a.in[4] + l * D; }
                else if ((r -= 1984) < 128) { W = a.in[12] + (size_t)l * 512 * D; K_ = 512; N_ = D; WT = WB + O_WBA; }
                else if ((r -= 128) < 128) { W = a.in[13] + (size_t)l * 512 * D; K_ = 512; N_ = D; WT = WB + O_WBB; }
                else if ((r -= 128) < 256) { W = a.in[14] + (size_t)l * D * D; K_ = D; N_ = D; WT = WB + O_WBC; }
                else if ((r -= 256) < 256) { W = a.in[15] + (size_t)l * D * D; K_ = D; N_ = D; WT = WB + O_WOUT; }
                else if ((r -= 256) < 1408) { W = a.in[17] + (size_t)l * D * 2 * F; K_ = D; N_ = 2 * F; WT = WB + O_W2IN; gk = a.in[16] + l * D; sw = true; }
                else { r -= 1408; W = a.in[18] + (size_t)l * F * D; K_ = F; N_ = D; WT = WB + O_W2OUT; }
                transpose_item(W, K_, N_, WT, gk, sw, scr, r, lane_o);
            }
            {
                const float* wsrc = a.in[8] + (size_t)l * 65536;
                for (int i = bid * 512 + tid; i < 65536; i += G * 512) { const int tt = (i >> 7) & 127, s = i & 127; WB[O_WS + i] = (bf16_t)f2bf(s <= tt ? wsrc[i] : 0.f); }
            }
            if (l == 0) {
                const float* x = a.in[0];
                for (int m = gw; m < M; m += NGW) { const f32x4* xr = (const f32x4*)(x + (size_t)m * D) + lane; float s = 0.f; u32x2* o8 = (u32x2*)(XB + (size_t)m * D) + lane;
#pragma unroll
                    for (int j = 0; j < 4; ++j) { const f32x4 v = xr[64 * j]; s += (v[0] * v[0] + v[1] * v[1]) + (v[2] * v[2] + v[3] * v[3]); u32x2 w; w.x = pk2(v[0], v[1]); w.y = pk2(v[2], v[3]); o8[64 * j] = w; }
#pragma unroll
                    for (int o = 1; o < 64; o <<= 1) s += __shfl_xor(s, o);
                    if (lane == 0) *(f32x4*)(SS + (size_t)m * 4) = (f32x4){s, 0.f, 0.f, 0.f}; }
            }
            __syncthreads();
        } else if (k == 1 || k == 15) {
            pg8::Gemm g{XB, WB + (k == 1 ? O_W1IN : O_W2IN), M, 2 * F, D, D}; pg8::StaticOrder S; S.init(M, 2 * F, G, bid);
            pg8::EpiSwiglu E{H, SS + (size_t)(3 * l + (k == 1 ? 0 : 2)) * M * 4};
            pg8::gemm_phase<pg8::EpiSwiglu>(L, g, S, E);
        } else if (k == 2 || k == 16) {
            pg8::Gemm g{H, WB + (k == 2 ? O_W1OUT : O_W2OUT), M, D, F, F}; pg8::StaticOrder S; S.init(M, D, G, bid);
            const int sidx = 3 * l + (k == 2 ? 1 : 3);
            pg8::EpiResid E{(l == 0 && k == 2) ? a.in[0] : nullptr, XB, SS + (size_t)sidx * M * 4, 0.5f, (LAS float*)(L + 131072)};
            pg8::gemm_phase<pg8::EpiResid>(L, g, S, E);
        } else if (k == 8) {
            pg8::Gemm g{Mg, WB + O_WOUT, MH, D, D, ldg}; pg8::StaticOrder S; S.init(MH, D, G, bid);
            pg8::EpiResid E{nullptr, XB + rowoff * D, SS + (size_t)(3 * l + 2) * M * 4 + rowoff * 4, 1.0f, (LAS float*)(L + 131072)};
            pg8::gemm_phase<pg8::EpiResid>(L, g, S, E);
        } else if (k == 3) {
            pg8::Gemm g{XB + rowoff * D, WB + O_WIN, MH, PW, D, D}; pg8::StaticOrder S; S.init(MH, PW, G, bid);
            pg8::EpiInproj E{P, SS + (size_t)(3 * l + 1) * M * 4 + rowoff * 4};
            pg8::gemm_phase<pg8::EpiInproj>(L, g, S, E);
        } else if (k == 4) {
            if (G == 256 && NCH == 256) {
                const int x = bid & 7, kk = bid >> 3;
                unit_attn(L, P, a.in[10] + l * 8, 32 * x + kk, tid);
                unit_gmlp(L, P, WB + O_WS, a.in[7] + l * 512, a.in[9] + l * 512, 32 * x + kk, tid);
                int tk = tid; asm volatile("" : "+v"(tk));
                const int u0 = 128 * x + kk;
                KvRegs R; kv_load(R, P, u0, tk);
                for (int j = 0; j < 4; ++j) { const int u = u0 + 32 * j;
                    kv_store(L, R, u, tk); __syncthreads();
                    if (j < 3) kv_load(R, P, u + 32, tk);
                    kv_compute(L, KV, u, tk); __syncthreads(); }
            } else {
            int i = bid;
            for (; i < 2 * NCH; i += G) {
                if (i < NCH) unit_attn(L, P, a.in[10] + l * 8, i, tid);
                else unit_gmlp(L, P, WB + O_WS, a.in[7] + l * 512, a.in[9] + l * 512, i - NCH, tid);
            }
            if (i < 6 * NCH) {
                int tk = tid; asm volatile("" : "+v"(tk));
                KvRegs R; kv_load(R, P, i - 2 * NCH, tk);
                for (; i < 6 * NCH; i += G) { const int u = i - 2 * NCH;
                    kv_store(L, R, u, tk); __syncthreads();
                    if (i + G < 6 * NCH) kv_load(R, P, i + G - 2 * NCH, tk);
                    kv_compute(L, KV, u, tk); __syncthreads(); }
            }
            }
        } else if (k == 5) {
            phase_scan(KV, bid * 512 + tid, G * 512);
        } else if (k == 6) {
            if (G == 256 && NCH == 256) { const int u0 = 128 * (bid & 7) + (bid >> 3); int tk = tid; asm volatile("" : "+v"(tk)); RetRegs R; ret_load(R, P, u0, tk);
                for (int j = 0; j < 4; ++j) unit_ret(L, P, KV, a.in[11] + l * 1024, u0 + 32 * j, tid, R, (j < 3) ? u0 + 32 * (j + 1) : -1); }
            else if (bid < 4 * NCH) { int tk = tid; asm volatile("" : "+v"(tk)); RetRegs R; ret_load(R, P, bid, tk);
                for (int i = bid; i < 4 * NCH; i += G) unit_ret(L, P, KV, a.in[11] + l * 1024, i, tid, R, (i + G < 4 * NCH) ? i + G : -1); }
        } else if (k == 7) {
            for (int br = 0; br < 3; ++br) {
                const int gi = (br == 0) ? 2 : (br - 1);
                if (2 * br >= MK_P7) break;
                {   pg8::Gemm g{XB + rowoff * D, WB + O_WIN + (size_t)(PW + gi * D) * D, MH, D, D, D}; pg8::StaticOrder S; S.init(MH, D, G, bid);
                    pg8::EpiGate E{Gt, SS + (size_t)(3 * l + 1) * M * 4 + rowoff * 4, a.in[6] + l * 3 * D + gi * D, ldg, (MK_X2) ? OUT + rowoff * D : nullptr};
                    pg8::gemm_phase<pg8::EpiGate>(L, g, S, E);
#if MK_T10
                    {
                        asm volatile("s_waitcnt vmcnt(0)" ::: "memory"); __syncthreads();
                        pg8::Unit uu; for (int ui = 0; S.next(ui, uu); ++ui)
                            for (int e = tid; e < 256 * 256; e += 512) { const int r = e >> 8, c = e & 255; const size_t row = (size_t)uu.pm * 256 + r, col = (size_t)uu.pn * 256 + c;
                                OUT[(rowoff + row) * D + col] = bflo((unsigned)Gt[row * ldg + col]); }
                    }
#endif
                }
                if (2 * br + 1 >= MK_P7) break;
                {   pg8::Gemm g; pg8::StaticOrder S; S.init(MH, D, G, bid);
                    if (br == 0) g = pg8::Gemm{P + C_CG, WB + O_WBC, MH, D, D, PW}; else if (br == 1) g = pg8::Gemm{P + C_AU, WB + O_WBA, MH, D, 512, PW}; else g = pg8::Gemm{P + C_BQ, WB + O_WBB, MH, D, 512, PW};
                    pg8::EpiMerge E{Gt, Mg, br == 0 ? 1 : 0, ldg};
                    pg8::gemm_phase<pg8::EpiMerge>(L, g, S, E); }
            }
        } else {
#if MK_X2 || MK_T10
            continue;
#endif
#ifdef MK_DBG
#if MK_DELAY
            { const unsigned long long t0 = __builtin_amdgcn_s_memrealtime(); while (__builtin_amdgcn_s_memrealtime() - t0 < 30000ull) __builtin_amdgcn_s_sleep(32); }
            __builtin_amdgcn_fence(__ATOMIC_ACQUIRE, "agent"); asm volatile("s_waitcnt vmcnt(0)" ::: "memory"); __syncthreads();
#endif
            {   const bf16_t* src16 = (MK_DBG == 1) ? Gt : Mg;
                for (size_t i = (size_t)bid * 512 + tid; i < (size_t)M * D; i += (size_t)G * 512) { const size_t m = i >> 10, c = i & 1023; OUT[i] = (m < (size_t)MH) ? bflo((unsigned)src16[m * ldg + c]) : 0.f; } }
            continue;
#endif
            const int gw = bid * 8 + wave, NGW = G * 8; const float* fg = a.in[19]; const float* ss = SS + (size_t)6 * M * 4;
            for (int m = gw; m < M; m += NGW) { f32x4* xr = (f32x4*)(OUT + (size_t)m * D) + lane; const u32x2* xs = (const u32x2*)(XB + (size_t)m * D) + lane; const float r = row_rstd(ss, m);
#pragma unroll
                for (int j = 0; j < 4; ++j) { const u32x2 bw = xs[64 * j]; const f32x4 v = (f32x4){bflo(bw.x), bfhi(bw.x), bflo(bw.y), bfhi(bw.y)}; const f32x4 gq = *((const f32x4*)fg + lane + 64 * j); xr[64 * j] = v * r * gq; } }
        }
        if (pidx + 1 < a.ph_hi) {
            xcd_barrier(xbar);
            if (pidx == a.ph_lo) { asm volatile("s_waitcnt vmcnt(0) lgkmcnt(0)" ::: "memory"); __syncthreads(); cg::this_grid().sync();
                __builtin_amdgcn_fence(__ATOMIC_ACQUIRE, "agent"); asm volatile("s_waitcnt vmcnt(0)" ::: "memory"); __syncthreads(); }
        }
    }
}

extern "C" void kernel_launch(void* const* d_in, const int* in_sizes, int n_in, void* d_out, int out_size, void* d_ws, size_t ws_size, hipStream_t stream) {
    static int grid = 0;
    if (grid == 0) {
        if (n_in != 20 || in_sizes[0] != M * D || out_size != M * D || ws_size < WS_END) { fprintf(stderr, "kernel_launch: unexpected shapes / workspace (n_in %d, ws %zu, need %zu)\n", n_in, ws_size, (size_t)WS_END); grid = -1; return; }
        int dev = 0, cus = 0, per_cu = 0;
        hipGetDevice(&dev); hipDeviceGetAttribute(&cus, hipDeviceAttributeMultiprocessorCount, dev);
        if (hipFuncSetAttribute((const void*)mk_fwd, hipFuncAttributeMaxDynamicSharedMemorySize, LDS_BYTES) != hipSuccess) { fprintf(stderr, "kernel_launch: hipFuncSetAttribute failed\n"); grid = -1; return; }
        if (hipOccupancyMaxActiveBlocksPerMultiprocessor(&per_cu, (const void*)mk_fwd, 512, LDS_BYTES) != hipSuccess || per_cu < 1) { fprintf(stderr, "kernel_launch: occupancy query says %d\n", per_cu); per_cu = 1; }
        (void)hipGetLastError();
        grid = cus * 1;
    }
    if (grid < 0) return;
    (void)hipMemsetAsync((char*)d_ws + WS_BAR, 0, 16384, stream);
    Args a{};
    for (int i = 0; i < 20; ++i) a.in[i] = (const float*)d_in[i];
    a.out = (float*)d_out; a.ws = (unsigned char*)d_ws;
#if MK_MULTI
    for (int i = 0; i < ((MK_STOP < NPHASES) ? MK_STOP + 1 : NPHASES); ++i) { const int ph = (MK_STOP < NPHASES && i == MK_STOP) ? NPHASES - 1 : i; a.ph_lo = ph; a.ph_hi = ph + 1; hipLaunchKernelGGL(mk_fwd, dim3(grid), dim3(512), LDS_BYTES, stream, a); }
#else
    a.ph_lo = 0; a.ph_hi = (MK_REPBLK) ? NPHASES + 4 : (MK_REPPH >= 0) ? NPHASES + 1 : ((MK_STOP < NPHASES) ? MK_STOP + 1 : NPHASES);
    void* args[] = {&a};
    hipError_t e = hipLaunchCooperativeKernel((const void*)mk_fwd, dim3(grid), dim3(512), args, LDS_BYTES, stream);
    if (e != hipSuccess) fprintf(stderr, "cooperative launch failed: %s (grid %d)\n", hipGetErrorString(e), grid);
#endif
}
```

```cpp
#include <hip/hip_runtime.h>
#include <hip/hip_cooperative_groups.h>
#include <cstdio>
#include <cstdint>
namespace cg = cooperative_groups;

#ifndef MK_DELAY
#define MK_DELAY 0
#endif
#define MK_WTG 0
#define MK_T10 0
#ifndef MK_EXTRASYNC
#define MK_EXTRASYNC 0
#endif
#ifndef MK_REPPH
#define MK_REPPH -1
#endif
#ifndef MK_FENCE
#define MK_FENCE 4
#endif
#ifndef MK_REPBLK
#define MK_REPBLK 0
#endif
#ifndef MK_GOVL
#define MK_GOVL 0
#endif
#ifndef MK_SCRUB
#define MK_SCRUB 0
#endif
#ifndef MK_WTIN
#define MK_WTIN 0
#endif
#ifndef MK_X3
#define MK_X3 0
#endif
#ifndef MK_X2
#define MK_X2 0
#endif
#ifndef MK_P7
#define MK_P7 6
#endif
#ifndef MK_CGSYNC
#define MK_CGSYNC 0
#endif
#ifndef MK_MULTI
#define MK_MULTI 0
#endif

#define LAS __attribute__((address_space(3)))
typedef unsigned short bf16_t;
typedef short bf16x8 __attribute__((ext_vector_type(8)));
typedef float f32x4 __attribute__((ext_vector_type(4)));
typedef float f32x2 __attribute__((ext_vector_type(2)));
typedef unsigned u32x4 __attribute__((ext_vector_type(4)));
typedef unsigned u32x2 __attribute__((ext_vector_type(2)));

constexpr int M = 32768, D = 1024, F = 2816, NCHUNK = 256, DEPTH = 2;
constexpr int PW = 4864;
constexpr int C_AU = 0, C_AV = 512, C_BQ = 1024, C_BK = 1536, C_BV = 1664, C_CQ = 1792, C_CK = 2304, C_CV = 2816, C_CG = 3840;
constexpr int C_GT = 1792;
constexpr int C_MG = 2816;
constexpr float NORM_EPS = 1e-6f, GN_EPS = 1e-5f, LOG2E = 1.4426950408889634f;
#ifndef MK_NB
#define MK_NB 1
#endif
constexpr int NB = MK_NB;
constexpr int MH = M / NB, NCH = MH / 128;
constexpr int NPH_LAYER = 5 + 6 * NB, NPHASES = NPH_LAYER * DEPTH + 1;

constexpr size_t MiB = 1u << 20;
constexpr size_t WS_BAR = 0;
constexpr size_t WS_WB = 1 * MiB;
constexpr size_t WS_XB = 57 * MiB;
constexpr size_t WS_P = 121 * MiB;
constexpr size_t WS_KV = WS_P + (size_t)MH * PW * 2;
constexpr size_t WS_G = WS_KV + (size_t)MH * 2048;
constexpr size_t WS_MG = WS_G + (NB == 2 ? 64 * MiB : 0);
constexpr size_t WS_SSP = WS_MG + (NB == 2 ? 64 * MiB : 0);
constexpr size_t WS_END = WS_SSP + 4 * MiB;
static_assert(WS_END <= 512 * MiB && WS_P + (size_t)M * F * 2 <= WS_G, "d_ws map");
constexpr size_t O_W1IN = 0, O_W1OUT = 5767168, O_WIN = 8650752, O_WBA = 16777216, O_WBB = 17301504, O_WBC = 17825792,
                 O_WOUT = 18874368, O_W2IN = 19922944, O_W2OUT = 25690112, O_WS = 28573696, O_WEND = 28639232;
static_assert(O_WEND * 2 <= 56 * MiB, "weights fit");

__device__ __forceinline__ float bflo(unsigned w) { return __uint_as_float(w << 16); }
__device__ __forceinline__ float bfhi(unsigned w) { return __uint_as_float(w & 0xffff0000u); }
__device__ __forceinline__ unsigned f2bf(float f) { unsigned u = __float_as_uint(f); return (u + 0x7fffu + ((u >> 16) & 1u)) >> 16; }
__device__ __forceinline__ unsigned pk2(float lo, float hi) { return f2bf(lo) | (f2bf(hi) << 16); }
__device__ __forceinline__ float fexp2(float x) { return __builtin_amdgcn_exp2f(x); }
__device__ __forceinline__ float frcp(float x) { return __builtin_amdgcn_rcpf(x); }
__device__ __forceinline__ float sigmoid_f(float x) { return frcp(1.0f + fexp2(-x * LOG2E)); }
__device__ __forceinline__ float silu_f(float x) { return x * sigmoid_f(x); }
__device__ __forceinline__ float gelu_tanh_f(float x) { const float u = 0.7978845608028654f * (x + 0.044715f * x * x * x); return x * frcp(1.0f + fexp2(-2.0f * LOG2E * u)); }

__device__ __forceinline__ void st16_wt(void* p, u32x4 v) { asm volatile("global_store_dwordx4 %0, %1, off sc0 sc1" :: "v"(p), "v"(v) : "memory"); }
__device__ __forceinline__ void st8_wt(void* p, u32x2 v) { asm volatile("global_store_dwordx2 %0, %1, off sc0 sc1" :: "v"(p), "v"(v) : "memory"); }
__device__ __forceinline__ void st4_wt(void* p, float v) { asm volatile("global_store_dword %0, %1, off sc0 sc1" :: "v"(p), "v"(v) : "memory"); }
__device__ __forceinline__ float row_rstd(const float* ssp, int row) { const f32x4 p = *(const f32x4*)(ssp + (size_t)row * 4); return rsqrtf(((p[0] + p[1]) + (p[2] + p[3])) * (1.0f / D) + NORM_EPS); }

namespace pg8 {
constexpr int BM = 256, BK = 64, HALF = 128, HTB = HALF * BK * 2, STAGE_BYTES = 8 * HTB, NXCD = 8, WGM = 8;
__host__ __device__ __forceinline__ int lds_byte(int r, int c) { const int st = (r >> 4) * 2 + (c >> 5), rr = r & 15, cc = c & 31, ob = rr * 64 + cc * 2; return st * 1024 + (ob ^ (((ob >> 9) & 1) << 5)); }
__host__ __device__ __forceinline__ void stage_rc(int b, int& R, int& C) { const int st = b / 1024, sb = b % 1024, swz = sb ^ (((sb >> 9) & 1) << 5); R = (st >> 1) * 16 + swz / 64; C = (st & 1) * 32 + (swz % 64) / 2; }
__host__ __device__ __forceinline__ int perm32(int rho) { const int n = rho >> 4, i = rho & 15; return 8 * (i >> 2) + 4 * n + (i & 3); }

struct Unit { int pm, pn; };
struct Gemm { const bf16_t* A; const bf16_t* Bt; int M, N, K, lda; };

struct StaticOrder {
    int nM, nN, nwg, G, c;
    __device__ void init(int M_, int N_, int G_, int c_) { nM = M_ / BM; nN = N_ / BM; nwg = nM * nN; G = G_; c = c_; }
    __device__ bool next(int i, Unit& u) const {
        const long L = (long)i * G + c; if (L >= nwg) return false;
        int wgid = (int)L; { const int q = nwg / NXCD, r = nwg % NXCD, xcd = wgid % NXCD, off = wgid / NXCD; wgid = (xcd < r ? xcd * (q + 1) : r * (q + 1) + (xcd - r) * q) + off; }
        const int nig = WGM * nN, gid = wgid / nig, fm = gid * WGM, gsz = (nM - fm) < WGM ? (nM - fm) : WGM;
        u.pm = fm + ((wgid % nig) % gsz); u.pn = (wgid % nig) / gsz; return true;
    }
};
typedef __bf16 bf16x2_t __attribute__((ext_vector_type(2)));
__device__ __forceinline__ unsigned cvt_pk_bf16(float lo, float hi) { const f32x2 v = {lo, hi}; const bf16x2_t b = __builtin_convertvector(v, bf16x2_t); return __builtin_bit_cast(unsigned, b); }

template <class Epi>
__device__ __forceinline__ void gemm_phase(LAS unsigned char* lds, const Gemm g, const StaticOrder& S, const Epi& E) {
    int tid = threadIdx.x; asm volatile("" : "+v"(tid));
    const int wid = __builtin_amdgcn_readfirstlane(tid >> 6), lane = tid & 63, wr = wid >> 2, wc = wid & 3, fr = lane & 15, fq = lane >> 4;
    const int K = g.K, nt = K / BK, lda = g.lda;
    unsigned voffA[2], voffB[2];
#pragma unroll
    for (int i = 0; i < 2; ++i) { int R, C; stage_rc(tid * 16 + i * 8192, R, C); const int Rb = Epi::PERM ? ((R & ~31) + perm32(R & 31)) : R;
        voffA[i] = (unsigned)(R * lda + C) * 2u; voffB[i] = (unsigned)(Rb * K + C) * 2u; }
    const size_t kstep = (size_t)(BK * 2);
    const size_t hstepA = (size_t)HALF * lda * 2, hstepB = (size_t)HALF * K * 2;
    const size_t tstepA = 2 * hstepA, tstepB = 2 * hstepB;
    const unsigned ldsw = (unsigned)wid * 1024u;
    const int aoff = lds_byte(wr * 64 + fr, fq * 8), boff = lds_byte(wc * 32 + fr, fq * 8);
#define PG8_SA(b, h) (((b) * 2 + (h)) * HTB)
#define PG8_SB(b, h) ((4 + (b) * 2 + (h)) * HTB)
#define PG8_STAGE(bufoff, gbase, voff) do { _Pragma("unroll") for (int _i = 0; _i < 2; ++_i) \
        __builtin_amdgcn_global_load_lds((const unsigned*)((const char*)(gbase) + (voff)[_i]), (LAS unsigned*)(lds + (bufoff) + ldsw + _i * 8192), 16, 0, 0); } while (0)
#define PG8_LDA(dst, b, h) do { _Pragma("unroll") for (int m = 0; m < 4; ++m) _Pragma("unroll") for (int k = 0; k < 2; ++k) dst[m][k] = *(const LAS bf16x8*)(lds + PG8_SA(b, h) + aoff + m * 2048 + k * 1024); } while (0)
#define PG8_LDB(dst, b, h) do { _Pragma("unroll") for (int n = 0; n < 2; ++n) _Pragma("unroll") for (int k = 0; k < 2; ++k) dst[n][k] = *(const LAS bf16x8*)(lds + PG8_SB(b, h) + boff + n * 2048 + k * 1024); } while (0)
#define PG8_MMA(ai, bj, At, Bt) do { __builtin_amdgcn_s_setprio(1); _Pragma("unroll") for (int m = 0; m < 4; ++m) _Pragma("unroll") for (int n = 0; n < 2; ++n) _Pragma("unroll") for (int k = 0; k < 2; ++k) \
        acc[ai][bj][m][n] = __builtin_amdgcn_mfma_f32_16x16x32_bf16(Bt[n][k], At[m][k], acc[ai][bj][m][n], 0, 0, 0); __builtin_amdgcn_s_setprio(0); } while (0)
#define PG8_WAIT_V(n) asm volatile("s_waitcnt vmcnt(" #n ")" ::: "memory")
#define PG8_WAIT_L(n) asm volatile("s_waitcnt lgkmcnt(" #n ")" ::: "memory")
#define PG8_BAR __builtin_amdgcn_s_barrier()
#define PG8_SCHED __builtin_amdgcn_sched_barrier(0)
    Unit cur, nxt; int ui = 0;
    if (!S.next(0, cur)) return;
    f32x4 acc[2][2][4][2];
#pragma unroll
    for (int a = 0; a < 2; ++a)
#pragma unroll
        for (int b = 0; b < 2; ++b)
#pragma unroll
            for (int m = 0; m < 4; ++m)
#pragma unroll
                for (int n = 0; n < 2; ++n) acc[a][b][m][n] = (f32x4){0.f, 0.f, 0.f, 0.f};
    bf16x8 At[4][2], B0[2][2], B1[2][2];
    const char* cA = (const char*)g.A + (size_t)cur.pm * tstepA; const char* cB = (const char*)g.Bt + (size_t)cur.pn * tstepB;
    PG8_STAGE(PG8_SB(0, 0), cB, voffB); PG8_STAGE(PG8_SB(0, 1), cB + hstepB, voffB); PG8_STAGE(PG8_SA(0, 0), cA, voffA); PG8_STAGE(PG8_SA(0, 1), cA + hstepA, voffA);
    if (wr == 1) PG8_BAR;
    PG8_WAIT_V(2); PG8_BAR;
    PG8_STAGE(PG8_SB(1, 0), cB + kstep, voffB); PG8_STAGE(PG8_SA(1, 0), cA + kstep, voffA); PG8_STAGE(PG8_SB(1, 1), cB + hstepB + kstep, voffB);
    PG8_WAIT_V(6); PG8_BAR;
    for (;;) {
        const bool has_next = S.next(ui + 1, nxt);
        const char* nA = has_next ? (const char*)g.A + (size_t)nxt.pm * tstepA : cA; const char* nB = has_next ? (const char*)g.Bt + (size_t)nxt.pn * tstepB : cB;
        for (int t = 0; t < nt; t += 2) {
            const bool last = (t == nt - 2);
            const char* a1 = cA + (size_t)(t + 1) * kstep;
            const char* a2 = last ? nA : cA + (size_t)(t + 2) * kstep; const char* b2 = last ? nB : cB + (size_t)(t + 2) * kstep;
            const char* a3 = a2 + kstep; const char* b3 = b2 + kstep;
            PG8_LDB(B0, 0, 0); PG8_LDB(B1, 0, 1); PG8_SCHED; PG8_LDA(At, 0, 0); PG8_STAGE(PG8_SA(1, 1), a1 + hstepA, voffA);
            PG8_WAIT_V(8); PG8_WAIT_L(0); PG8_BAR; PG8_MMA(0, 0, At, B0); PG8_MMA(0, 1, At, B1); PG8_BAR; PG8_SCHED;
            PG8_LDA(At, 0, 1); PG8_STAGE(PG8_SB(0, 0), b2, voffB); PG8_STAGE(PG8_SB(0, 1), b2 + hstepB, voffB); PG8_STAGE(PG8_SA(0, 0), a2, voffA);
            PG8_WAIT_V(8); PG8_WAIT_L(0); PG8_BAR; PG8_MMA(1, 0, At, B0); PG8_MMA(1, 1, At, B1); PG8_BAR; PG8_SCHED;
            PG8_LDB(B0, 1, 0); PG8_LDB(B1, 1, 1); PG8_SCHED; PG8_LDA(At, 1, 0); PG8_STAGE(PG8_SA(0, 1), a2 + hstepA, voffA);
            PG8_WAIT_V(8); PG8_WAIT_L(0); PG8_BAR; PG8_MMA(0, 0, At, B0); PG8_MMA(0, 1, At, B1); PG8_BAR; PG8_SCHED;
            PG8_LDA(At, 1, 1); PG8_STAGE(PG8_SB(1, 0), b3, voffB); PG8_STAGE(PG8_SB(1, 1), b3 + hstepB, voffB); PG8_STAGE(PG8_SA(1, 0), a3, voffA);
            PG8_WAIT_V(8); PG8_WAIT_L(0); PG8_BAR; PG8_MMA(1, 0, At, B0); PG8_MMA(1, 1, At, B1); PG8_BAR; PG8_SCHED;
        }
        if (wr == 0) PG8_BAR;
        E(acc, cur, wr, wc, fr, fq);
        if (!has_next) break;
#pragma unroll
        for (int a = 0; a < 2; ++a)
#pragma unroll
            for (int b = 0; b < 2; ++b)
#pragma unroll
                for (int m = 0; m < 4; ++m)
#pragma unroll
                    for (int n = 0; n < 2; ++n) acc[a][b][m][n] = (f32x4){0.f, 0.f, 0.f, 0.f};
        cur = nxt; cA = nA; cB = nB; ++ui;
        if (wr == 1) PG8_BAR;
    }
    PG8_WAIT_V(0);
    PG8_BAR;
#undef PG8_SA
#undef PG8_SB
#undef PG8_STAGE
#undef PG8_LDA
#undef PG8_LDB
#undef PG8_MMA
#undef PG8_WAIT_V
#undef PG8_WAIT_L
#undef PG8_BAR
#undef PG8_SCHED
}

struct EpiSwiglu {
    static constexpr bool PERM = true;
    bf16_t* H; const float* ss;
    __device__ __forceinline__ void operator()(const f32x4 (&acc)[2][2][4][2], const Unit& u, int wr, int wc, int fr, int fq) const {
        const int row0 = u.pm * BM + wr * 64 + fr, col0 = u.pn * 128 + wc * 32 + 8 * fq;
#pragma unroll
        for (int ai = 0; ai < 2; ++ai)
#pragma unroll
            for (int m = 0; m < 4; ++m) { const int row = row0 + ai * HALF + m * 16; const float r = row_rstd(ss, row);
                float h[8];
#pragma unroll
                for (int n = 0; n < 2; ++n)
#pragma unroll
                    for (int e = 0; e < 4; ++e) { const float a = acc[ai][0][m][n][e] * r, b = acc[ai][1][m][n][e] * r; h[n * 4 + e] = silu_f(a) * b; }
                u32x4 w; w.x = cvt_pk_bf16(h[0], h[1]); w.y = cvt_pk_bf16(h[2], h[3]); w.z = cvt_pk_bf16(h[4], h[5]); w.w = cvt_pk_bf16(h[6], h[7]);
                *(u32x4*)(H + (size_t)row * F + col0) = w; }
    }
};
struct EpiResid {
    static constexpr bool PERM = true;
    const float* base32; bf16_t* xb; float* ssn; float scale; LAS float* red;
    __device__ __forceinline__ void operator()(const f32x4 (&acc)[2][2][4][2], const Unit& u, int wr, int wc, int fr, int fq) const {
        const int row0 = u.pm * BM + wr * 64 + fr, col0 = u.pn * BM + wc * 32 + 8 * fq;
#pragma unroll
        for (int ai = 0; ai < 2; ++ai)
#pragma unroll
            for (int m = 0; m < 4; ++m) { const int row = row0 + ai * HALF + m * 16; const size_t off = (size_t)row * D + col0; float q = 0.f;
#pragma unroll
                for (int bj = 0; bj < 2; ++bj) { const size_t o2 = off + bj * HALF; f32x4 b0, b1;
                    if (base32) { b0 = *(const f32x4*)(base32 + o2); b1 = *(const f32x4*)(base32 + o2 + 4); }
                    else { const u32x4 bw = *(const u32x4*)(xb + o2); b0 = (f32x4){bflo(bw.x), bfhi(bw.x), bflo(bw.y), bfhi(bw.y)}; b1 = (f32x4){bflo(bw.z), bfhi(bw.z), bflo(bw.w), bfhi(bw.w)}; }
                    const f32x4 o0 = b0 + acc[ai][bj][m][0] * scale, o1 = b1 + acc[ai][bj][m][1] * scale;
                    u32x4 w; w.x = cvt_pk_bf16(o0[0], o0[1]); w.y = cvt_pk_bf16(o0[2], o0[3]); w.z = cvt_pk_bf16(o1[0], o1[1]); w.w = cvt_pk_bf16(o1[2], o1[3]);
                    *(u32x4*)(xb + o2) = w;
                    q += ((o0[0] * o0[0] + o0[1] * o0[1]) + (o0[2] * o0[2] + o0[3] * o0[3])) + ((o1[0] * o1[0] + o1[1] * o1[1]) + (o1[2] * o1[2] + o1[3] * o1[3])); }
                q += __shfl_xor(q, 16); q += __shfl_xor(q, 32);
                if (fq == 0) red[(ai * HALF + wr * 64 + m * 16 + fr) * 4 + wc] = q;
                if ((m & (MK_FENCE - 1)) == MK_FENCE - 1) asm volatile("" ::: "memory"); }
        asm volatile("s_waitcnt lgkmcnt(0)" ::: "memory"); __builtin_amdgcn_s_barrier(); asm volatile("" ::: "memory");
        if (wr == 0) { const int t = wc * 64 + fq * 16 + fr; const f32x4 p = *(const LAS f32x4*)(red + t * 4);
            ssn[((size_t)u.pm * BM + t) * 4 + u.pn] = (p[0] + p[1]) + (p[2] + p[3]); }
    }
};
struct EpiInproj {
    static constexpr bool PERM = true;
    bf16_t* P; const float* ss;
    __device__ __forceinline__ void operator()(const f32x4 (&acc)[2][2][4][2], const Unit& u, int wr, int wc, int fr, int fq) const {
        if (u.pn < 4) run<1>(acc, u, wr, wc, fr, fq); else if (u.pn >= 15) run<2>(acc, u, wr, wc, fr, fq); else run<0>(acc, u, wr, wc, fr, fq);
    }
    template <int ACT> __device__ __forceinline__ void run(const f32x4 (&acc)[2][2][4][2], const Unit& u, int wr, int wc, int fr, int fq) const {
        const int row0 = u.pm * BM + wr * 64 + fr, col0 = u.pn * BM + wc * 32 + 8 * fq;
#pragma unroll
        for (int ai = 0; ai < 2; ++ai)
#pragma unroll
            for (int m = 0; m < 4; ++m) { const int row = row0 + ai * HALF + m * 16; const float r = row_rstd(ss, row);
#pragma unroll
                for (int bj = 0; bj < 2; ++bj) { float h[8];
#pragma unroll
                    for (int n = 0; n < 2; ++n)
#pragma unroll
                        for (int e = 0; e < 4; ++e) { const float v = acc[ai][bj][m][n][e] * r; h[n * 4 + e] = (ACT == 1) ? gelu_tanh_f(v) : ((ACT == 2) ? silu_f(v) : v); }
                    u32x4 w; w.x = cvt_pk_bf16(h[0], h[1]); w.y = cvt_pk_bf16(h[2], h[3]); w.z = cvt_pk_bf16(h[4], h[5]); w.w = cvt_pk_bf16(h[6], h[7]);
#if MK_WTIN
                    asm volatile("global_store_dwordx4 %0, %1, off sc0 sc1" :: "v"(P + (size_t)row * PW + col0 + bj * HALF), "v"(w) : "memory"); } }
#else
                    *(u32x4*)(P + (size_t)row * PW + col0 + bj * HALF) = w; } }
#endif
    }
};
struct EpiGate {
    static constexpr bool PERM = true;
    bf16_t* G; const float* ss; const float* bias; int ld; float* dbg32;
    __device__ __forceinline__ void operator()(const f32x4 (&acc)[2][2][4][2], const Unit& u, int wr, int wc, int fr, int fq) const {
        const int row0 = u.pm * BM + wr * 64 + fr, col0 = u.pn * BM + wc * 32 + 8 * fq;
#pragma unroll
        for (int ai = 0; ai < 2; ++ai)
#pragma unroll
            for (int m = 0; m < 4; ++m) { const int row = row0 + ai * HALF + m * 16; const float r = row_rstd(ss, row);
#pragma unroll
                for (int bj = 0; bj < 2; ++bj) { float h[8]; const f32x4 b0 = *(const f32x4*)(bias + col0 + bj * HALF), b1 = *(const f32x4*)(bias + col0 + bj * HALF + 4);
#pragma unroll
#ifdef MK_X1
                    for (int e = 0; e < 4; ++e) { h[e] = sigmoid_f(acc[ai][bj][m][0][e] * 0.03f + 0.f * (r + b0[e])); h[4 + e] = sigmoid_f(acc[ai][bj][m][1][e] * 0.03f + 0.f * b1[e]); }
#else
                    for (int e = 0; e < 4; ++e) { h[e] = sigmoid_f(acc[ai][bj][m][0][e] * r + b0[e]); h[4 + e] = sigmoid_f(acc[ai][bj][m][1][e] * r + b1[e]); }
#endif
                    u32x4 w; w.x = cvt_pk_bf16(h[0], h[1]); w.y = cvt_pk_bf16(h[2], h[3]); w.z = cvt_pk_bf16(h[4], h[5]); w.w = cvt_pk_bf16(h[6], h[7]);
#if MK_WTG
                    asm volatile("global_store_dwordx4 %0, %1, off sc0 sc1" :: "v"(G + (size_t)row * ld + col0 + bj * HALF), "v"(w) : "memory");
#else
                    *(u32x4*)(G + (size_t)row * ld + col0 + bj * HALF) = w;
#endif
                    if (dbg32) { *(f32x4*)(dbg32 + (size_t)row * D + col0 + bj * HALF) = (f32x4){h[0], h[1], h[2], h[3]}; *(f32x4*)(dbg32 + (size_t)row * D + col0 + bj * HALF + 4) = (f32x4){h[4], h[5], h[6], h[7]}; } }
                if ((m & (MK_FENCE - 1)) == MK_FENCE - 1) asm volatile("" ::: "memory"); }
    }
};
struct EpiMerge {
    static constexpr bool PERM = true;
    const bf16_t* G; bf16_t* Mg; int first, ld;
    __device__ __forceinline__ void operator()(const f32x4 (&acc)[2][2][4][2], const Unit& u, int wr, int wc, int fr, int fq) const {
        const int row0 = u.pm * BM + wr * 64 + fr, col0 = u.pn * BM + wc * 32 + 8 * fq;
#pragma unroll
        for (int ai = 0; ai < 2; ++ai)
#pragma unroll
            for (int m = 0; m < 4; ++m) { const int row = row0 + ai * HALF + m * 16;
#pragma unroll
                for (int bj = 0; bj < 2; ++bj) { const size_t off = (size_t)row * ld + col0 + bj * HALF;
                    const u32x4 gv = *(const u32x4*)(G + off); u32x4 mv = (u32x4){0u, 0u, 0u, 0u}; if (!first) mv = *(const u32x4*)(Mg + off);
                    float h[8];
#pragma unroll
                    for (int n = 0; n < 2; ++n) { const unsigned g0 = n ? gv.z : gv.x, g1 = n ? gv.w : gv.y, m0 = n ? mv.z : mv.x, m1 = n ? mv.w : mv.y;
                        h[n * 4 + 0] = bflo(m0) + bflo(g0) * acc[ai][bj][m][n][0]; h[n * 4 + 1] = bfhi(m0) + bfhi(g0) * acc[ai][bj][m][n][1];
                        h[n * 4 + 2] = bflo(m1) + bflo(g1) * acc[ai][bj][m][n][2]; h[n * 4 + 3] = bfhi(m1) + bfhi(g1) * acc[ai][bj][m][n][3]; }
                    u32x4 w; w.x = cvt_pk_bf16(h[0], h[1]); w.y = cvt_pk_bf16(h[2], h[3]); w.z = cvt_pk_bf16(h[4], h[5]); w.w = cvt_pk_bf16(h[6], h[7]);
                    *(u32x4*)(Mg + off) = w; }
                if ((m & (MK_FENCE - 1)) == MK_FENCE - 1) asm volatile("" ::: "memory"); }
    }
};
}

template <int KSTEPS>
__device__ __forceinline__ f32x4 mma_k(const LAS unsigned char* pa, const LAS unsigned char* pb, f32x4 acc) {
#pragma unroll
    for (int s = 0; s < KSTEPS; ++s) { const bf16x8 a = *(const LAS bf16x8*)(pa + s * 64); const bf16x8 b = *(const LAS bf16x8*)(pb + s * 64);
        acc = __builtin_amdgcn_mfma_f32_16x16x32_bf16(a, b, acc, 0, 0, 0); }
    return acc;
}
typedef short v4i16 __attribute__((ext_vector_type(4)));
__device__ __forceinline__ bf16x8 ld_tr_frag(const LAS unsigned char* img, int pitch, int tok0, int ch0, int lane) {
    const int g = lane >> 4, q = (lane & 15) >> 2, p = lane & 3;
    const LAS unsigned char* a = img + (tok0 + 8 * g + q) * pitch + (ch0 + 4 * p) * 2;
    const v4i16 lo = __builtin_amdgcn_ds_read_tr16_b64_v4i16((LAS v4i16*)a);
    const v4i16 hi = __builtin_amdgcn_ds_read_tr16_b64_v4i16((LAS v4i16*)(a + 4 * pitch));
    return __builtin_shufflevector(lo, hi, 0, 1, 2, 3, 4, 5, 6, 7);
}
__device__ __forceinline__ void lds_barrier() { asm volatile("s_waitcnt lgkmcnt(0)" ::: "memory"); __builtin_amdgcn_s_barrier(); asm volatile("" ::: "memory"); }
__device__ __forceinline__ void lds_st16(LAS unsigned char* p, unsigned v) { *(LAS unsigned short*)p = (unsigned short)v; }

__device__ __forceinline__ void unit_gmlp(LAS unsigned char* L, bf16_t* P, const bf16_t* WSb, const float* vnorm, const float* bs, int ci, int tid) {
    asm volatile("" : "+v"(tid));
    const int lane = tid & 63, wid = tid >> 6, l15 = lane & 15, lq = lane >> 4;
    constexpr int PT = 272;
    LAS unsigned char* Wl = L; LAS unsigned char* VT = L + 34816; LAS float* rs = (LAS float*)(L + 69632);
    bf16_t* Prow = P + (size_t)ci * 128 * PW;
    {
        const int t = tid >> 2, part = tid & 3; const bf16_t* src = Prow + (size_t)t * PW + C_AV + part * 128; float s = 0.f;
#pragma unroll 4
        for (int i = 0; i < 16; ++i) { const u32x4 v = *((const u32x4*)(src + 8 * i));
            s += bflo(v.x) * bflo(v.x) + bfhi(v.x) * bfhi(v.x) + bflo(v.y) * bflo(v.y) + bfhi(v.y) * bfhi(v.y) + bflo(v.z) * bflo(v.z) + bfhi(v.z) * bfhi(v.z) + bflo(v.w) * bflo(v.w) + bfhi(v.w) * bfhi(v.w); }
        s += __shfl_xor(s, 1); s += __shfl_xor(s, 2);
        if (part == 0) rs[t] = rsqrtf(s * (1.0f / 512.0f) + NORM_EPS);
    }
    lds_barrier();
    for (int g = 0; g < 4; ++g) {
        for (int i = tid; i < 2048; i += 512) { const int r = i >> 4, c = i & 15; *(LAS u32x4*)(Wl + r * PT + c * 16) = *((const u32x4*)(WSb + g * 16384 + r * 128 + c * 8)); }
        for (int i = tid; i < 2048; i += 512) { const int r = i >> 4, c = i & 15; const float rr = rs[r]; const float* gn = vnorm + g * 128 + c * 8;
            const u32x4 v = *((const u32x4*)(Prow + (size_t)r * PW + C_AV + g * 128 + c * 8)); const f32x4 g0 = *(const f32x4*)gn, g1 = *(const f32x4*)(gn + 4);
            u32x4 o; o.x = pk2(bflo(v.x) * rr * g0[0], bfhi(v.x) * rr * g0[1]); o.y = pk2(bflo(v.y) * rr * g0[2], bfhi(v.y) * rr * g0[3]);
            o.z = pk2(bflo(v.z) * rr * g1[0], bfhi(v.z) * rr * g1[1]); o.w = pk2(bflo(v.w) * rr * g1[2], bfhi(v.w) * rr * g1[3]);
            *(LAS u32x4*)(VT + r * PT + c * 16) = o; }
        lds_barrier();
        {   bf16x8 af[4];
#pragma unroll
            for (int s = 0; s < 4; ++s) af[s] = ld_tr_frag(VT, PT, 32 * s, 16 * wid, lane);
#pragma unroll
            for (int tt = 0; tt < 8; ++tt) { const LAS unsigned char* pb = Wl + (16 * tt + l15) * PT + lq * 16;
                f32x4 acc = (f32x4){0.f, 0.f, 0.f, 0.f};
#pragma unroll
                for (int s = 0; s < 4; ++s) acc = __builtin_amdgcn_mfma_f32_16x16x32_bf16(af[s], *(const LAS bf16x8*)(pb + s * 64), acc, 0, 0, 0);
                const int t = 16 * tt + l15, d = 16 * wid + 4 * lq; const float b = bs[g * 128 + t];
                bf16_t* up = Prow + (size_t)t * PW + C_AU + g * 128 + d; const u32x2 uv = *((const u32x2*)up);
                u32x2 o; o.x = pk2(bflo(uv.x) * (acc[0] + b), bfhi(uv.x) * (acc[1] + b)); o.y = pk2(bflo(uv.y) * (acc[2] + b), bfhi(uv.y) * (acc[3] + b));
                *(u32x2*)up = o; }
        }
        lds_barrier();
    }
}

__device__ __forceinline__ void unit_attn(LAS unsigned char* L, bf16_t* P, const float* sinks, int ci, int tid) {
    asm volatile("" : "+v"(tid));
    const int lane = tid & 63, wid = tid >> 6, l15 = lane & 15, lq = lane >> 4;
    constexpr int PK = 144, PV = 144, PP = 336;
    LAS unsigned char* Kl = L; LAS unsigned char* VT = L + 36864; LAS unsigned char* Pl = L + 73728 + wid * 5376;
    const int n = ci & 127; const long rowbase = (long)ci * 128 - 128;
    for (int kvh = 0; kvh < 2; ++kvh) {
        for (int i = tid; i < 2048; i += 512) { const int r = i >> 3, c = i & 7; u32x4 v = (u32x4){0u, 0u, 0u, 0u};
            if (n > 0 || r >= 128) v = *((const u32x4*)(P + (size_t)(rowbase + r) * PW + C_BK + kvh * 64 + c * 8));
            *(LAS u32x4*)(Kl + r * PK + c * 16) = v; }
        for (int i = tid; i < 2048; i += 512) { const int r = i >> 3, c = i & 7; u32x4 v = (u32x4){0u, 0u, 0u, 0u};
            if (n > 0 || r >= 128) v = *(const u32x4*)(P + (size_t)(rowbase + r) * PW + C_BV + kvh * 64 + c * 8);
            *(LAS u32x4*)(VT + r * PV + c * 16) = v; }
        lds_barrier();
        const bf16_t* qq0 = P + ((size_t)ci * 128 + 16 * ((wid & 1) * 4) + l15) * PW + C_BQ + (kvh * 4 + (wid >> 1)) * 64 + lq * 8;
        bf16x8 qn0 = *(const bf16x8*)qq0, qn1 = *(const bf16x8*)(qq0 + 32);
        for (int it = 0; it < 4; ++it) {
            const bf16x8 q0 = qn0, q1 = qn1;
            if (it < 3) { const bf16_t* qq = qq0 + (size_t)(16 * (it + 1)) * PW; qn0 = *(const bf16x8*)qq; qn1 = *(const bf16x8*)(qq + 32); }
            const int g = wid >> 1, qt = (wid & 1) * 4 + it, h = kvh * 4 + g;
            const float slope = fexp2(-(float)(h + 1)), sink = sinks[h];
            const size_t qrow = (size_t)ci * 128 + 16 * qt + l15;
            bf16_t* qp = P + qrow * PW + C_BQ + h * 64;
            const int kt0 = qt & ~1;
            f32x4 sc[10];
#pragma unroll
            for (int i = 0; i < 10; ++i) { const LAS unsigned char* pa = Kl + (16 * (kt0 + i) + l15) * PK + lq * 16;
                f32x4 a = __builtin_amdgcn_mfma_f32_16x16x32_bf16(*(const LAS bf16x8*)pa, q0, (f32x4){0.f, 0.f, 0.f, 0.f}, 0, 0, 0);
                sc[i] = __builtin_amdgcn_mfma_f32_16x16x32_bf16(*(const LAS bf16x8*)(pa + 64), q1, a, 0, 0, 0); }
            const int qpos = 128 + 16 * qt + l15; float mx = sink;
#pragma unroll
            for (int i = 0; i < 10; ++i)
#pragma unroll
                for (int j = 0; j < 4; ++j) { const int kpos = 16 * (kt0 + i) + 4 * lq + j, dist = qpos - kpos; const bool valid = dist >= 0 && dist < 128 && (n > 0 || kpos >= 128);
                    const float s = valid ? sc[i][j] * 0.125f - slope * (float)dist : -INFINITY; sc[i][j] = s; mx = fmaxf(mx, s); }
            mx = fmaxf(mx, __shfl_xor(mx, 16)); mx = fmaxf(mx, __shfl_xor(mx, 32));
            float sum = 0.f;
#pragma unroll
            for (int i = 0; i < 10; ++i)
#pragma unroll
                for (int j = 0; j < 4; ++j) { const float p = fexp2((sc[i][j] - mx) * LOG2E); sc[i][j] = p; sum += p; }
            sum += __shfl_xor(sum, 16); sum += __shfl_xor(sum, 32);
            sum += fexp2((sink - mx) * LOG2E);
            const float inv = 1.0f / sum;
#pragma unroll
            for (int i = 0; i < 10; ++i) { u32x2 w; w.x = pk2(sc[i][0] * inv, sc[i][1] * inv); w.y = pk2(sc[i][2] * inv, sc[i][3] * inv);
                *(LAS u32x2*)(Pl + l15 * PP + (16 * i + 4 * lq) * 2) = w; }
            asm volatile("s_waitcnt lgkmcnt(0)" ::: "memory");
#pragma unroll
            for (int dt = 0; dt < 4; ++dt) { f32x4 acc = (f32x4){0.f, 0.f, 0.f, 0.f};
#pragma unroll
                for (int s5 = 0; s5 < 5; ++s5) { const bf16x8 a = ld_tr_frag(VT, PV, 16 * kt0 + 32 * s5, 16 * dt, lane);
                    const bf16x8 b = *(const LAS bf16x8*)(Pl + l15 * PP + (32 * s5 + 8 * lq) * 2);
                    acc = __builtin_amdgcn_mfma_f32_16x16x32_bf16(a, b, acc, 0, 0, 0); }
                u32x2 o; o.x = pk2(acc[0], acc[1]); o.y = pk2(acc[2], acc[3]);
                *(u32x2*)(qp + 16 * dt + 4 * lq) = o; }
            asm volatile("s_waitcnt lgkmcnt(0)" ::: "memory");
        }
        lds_barrier();
    }
}

struct KvRegs { u32x4 v[8], k[4]; };
__device__ __forceinline__ void kv_load(KvRegs& R, const bf16_t* P, int u, int tid) {
    const int ci = u >> 2, h = u & 3; const bf16_t* Pr = P + (size_t)ci * 128 * PW;
#pragma unroll
    for (int j = 0; j < 8; ++j) { const int i = tid + 512 * j, r = i >> 5, c = i & 31; R.v[j] = *((const u32x4*)(Pr + (size_t)r * PW + C_CV + h * 256 + c * 8)); }
#pragma unroll
    for (int j = 0; j < 4; ++j) { const int i = tid + 512 * j, r = i >> 4, c = i & 15; R.k[j] = *((const u32x4*)(Pr + (size_t)r * PW + C_CK + h * 128 + c * 8)); }
}
__device__ __forceinline__ void kv_store(LAS unsigned char* L, const KvRegs& R, int u, int tid) {
    constexpr int PVI = 528, PKI = 272; LAS unsigned char* Vi = L; LAS unsigned char* Ki = L + 128 * PVI;
    const float lg = log2f(1.0f - exp2f(-5.0f - (float)(u & 3)));
#pragma unroll
    for (int j = 0; j < 8; ++j) { const int i = tid + 512 * j, r = i >> 5, c = i & 31; *(LAS u32x4*)(Vi + r * PVI + c * 16) = R.v[j]; }
#pragma unroll
    for (int j = 0; j < 4; ++j) { const int i = tid + 512 * j, r = i >> 4, c = i & 15; const float kw = 0.08838834764831845f * fexp2(lg * (float)(127 - r)); const u32x4 v = R.k[j];
        u32x4 o; o.x = pk2(bflo(v.x) * kw, bfhi(v.x) * kw); o.y = pk2(bflo(v.y) * kw, bfhi(v.y) * kw); o.z = pk2(bflo(v.z) * kw, bfhi(v.z) * kw); o.w = pk2(bflo(v.w) * kw, bfhi(v.w) * kw);
        *(LAS u32x4*)(Ki + r * PKI + c * 16) = o; }
}
__device__ __forceinline__ void kv_compute(LAS unsigned char* L, bf16_t* KV, int u, int tid) {
    const int lane = tid & 63, wid = tid >> 6, l15 = lane & 15, lq = lane >> 4;
    constexpr int PVI = 528, PKI = 272; const LAS unsigned char* Vi = L; const LAS unsigned char* Ki = L + 128 * PVI;
    bf16_t* out = KV + (size_t)u * 32768;
    bf16x8 bfr[2][4];
#pragma unroll
    for (int ee = 0; ee < 2; ++ee)
#pragma unroll
        for (int s = 0; s < 4; ++s) bfr[ee][s] = ld_tr_frag(Vi, PVI, 32 * s, 16 * (2 * wid + ee), lane);
#pragma unroll 2
    for (int dt = 0; dt < 8; ++dt) { bf16x8 af[4];
#pragma unroll
        for (int s = 0; s < 4; ++s) af[s] = ld_tr_frag(Ki, PKI, 32 * s, 16 * dt, lane);
#pragma unroll
        for (int ee = 0; ee < 2; ++ee) { f32x4 acc = (f32x4){0.f, 0.f, 0.f, 0.f};
#pragma unroll
            for (int s = 0; s < 4; ++s) acc = __builtin_amdgcn_mfma_f32_16x16x32_bf16(af[s], bfr[ee][s], acc, 0, 0, 0);
            u32x2 o; o.x = pk2(acc[0], acc[1]); o.y = pk2(acc[2], acc[3]);
            *(u32x2*)(out + (16 * (2 * wid + ee) + l15) * 128 + 16 * dt + 4 * lq) = o; } }
}

__device__ __forceinline__ void phase_scan(bf16_t* KV, int gtid, int gthreads) {
    for (int w = gtid; w < 65536 * (MH / 16384); w += gthreads) {
        const int b = w >> 16, h = (w >> 14) & 3, e2 = w & 16383;
        const float decay = exp2f(128.0f * log2f(1.0f - exp2f(-5.0f - (float)h)));
        float st0 = 0.f, st1 = 0.f;
        unsigned* base = (unsigned*)(KV + ((size_t)(b * 128) * 4 + h) * 32768) + e2;
        for (int n0 = 0; n0 < 128; n0 += 16) {
            unsigned v[16];
#pragma unroll
            for (int i = 0; i < 16; ++i) v[i] = *(base + (size_t)(n0 + i) * 4 * 16384);
#pragma unroll
            for (int i = 0; i < 16; ++i) { base[(size_t)(n0 + i) * 4 * 16384] = pk2(st0, st1);
                st0 = decay * st0 + bflo(v[i]); st1 = decay * st1 + bfhi(v[i]); }
        }
    }
}

struct RetRegs { u32x4 q[4], k[4]; };
__device__ __forceinline__ void ret_load(RetRegs& R, const bf16_t* P, int u, int tid) {
    const int ci = u >> 2, h = u & 3;
#pragma unroll
    for (int j = 0; j < 4; ++j) { const int i = tid + 512 * j, r = i >> 4, c = i & 15; const bf16_t* src = P + ((size_t)ci * 128 + r) * PW + h * 128 + c * 8;
        R.q[j] = *((const u32x4*)(src + C_CQ)); R.k[j] = *((const u32x4*)(src + C_CK)); }
}
__device__ __forceinline__ void unit_ret(LAS unsigned char* L, bf16_t* P, const bf16_t* KV, const float* gn, int u, int tid, RetRegs& RR, int u_next) {
    asm volatile("" : "+v"(tid));
    const int lane = tid & 63, wid = tid >> 6, l15 = lane & 15, lq = lane >> 4;
    constexpr int PT = 272, R = 34816;
    LAS unsigned char* Ql = L; LAS unsigned char* Kl = L + R; LAS unsigned char* Pl = L + 2 * R; LAS unsigned char* Sl = L + 3 * R;
    const int ci = u >> 2, h = u & 3; const size_t row0 = (size_t)ci * 128;
    const float lg = log2f(1.0f - exp2f(-5.0f - (float)h));
#pragma unroll
    for (int j = 0; j < 4; ++j) { const int i = tid + 512 * j, r = i >> 4, c = i & 15; *(LAS u32x4*)(Ql + r * PT + c * 16) = RR.q[j]; *(LAS u32x4*)(Kl + r * PT + c * 16) = RR.k[j]; }
    lds_barrier();
    const int t = 16 * wid + l15;
    u32x4 pv[4], ps[4];
#pragma unroll
    for (int j = 0; j < 4; ++j) { const int i = tid + 512 * j, r = i >> 4, c = i & 15;
        pv[j] = *((const u32x4*)(P + (row0 + r) * PW + C_CV + h * 256 + c * 8));
        ps[j] = *((const u32x4*)(KV + (size_t)u * 32768 + r * 128 + c * 8)); }
    {   const LAS unsigned char* pb = Ql + t * PT + lq * 16;
        for (int st = 0; st < 8; ++st) { f32x4 acc = (f32x4){0.f, 0.f, 0.f, 0.f};
            if (st <= wid) { const LAS unsigned char* pa = Kl + (16 * st + l15) * PT + lq * 16; acc = mma_k<4>(pa, pb, acc); }
            float v[4];
#pragma unroll
            for (int j = 0; j < 4; ++j) { const int s = 16 * st + 4 * lq + j; v[j] = (s <= t) ? acc[j] * 0.08838834764831845f * fexp2(lg * (float)(t - s)) : 0.f; }
            u32x2 w; w.x = pk2(v[0], v[1]); w.y = pk2(v[2], v[3]);
            *(LAS u32x2*)(Pl + t * PT + (16 * st + 4 * lq) * 2) = w; }
    }
    lds_barrier();
    f32x4 o[16];
    const float qw = fexp2(lg * (float)(t + 1));
#pragma unroll
    for (int hf = 0; hf < 2; ++hf) {
#pragma unroll
        for (int j = 0; j < 4; ++j) { const int i = tid + 512 * j, r = i >> 4, c = i & 15;
            *(LAS u32x4*)(Kl + r * PT + c * 16) = pv[j]; *(LAS u32x4*)(Sl + r * PT + c * 16) = ps[j]; }
        lds_barrier();
        if (hf == 0) {
#pragma unroll
            for (int j = 0; j < 4; ++j) { const int i = tid + 512 * j, r = i >> 4, c = i & 15;
                pv[j] = *((const u32x4*)(P + (row0 + r) * PW + C_CV + h * 256 + 128 + c * 8));
                ps[j] = *((const u32x4*)(KV + (size_t)u * 32768 + (128 + r) * 128 + c * 8)); } }
        const LAS unsigned char* pbP = Pl + t * PT + lq * 16; const LAS unsigned char* pbQ = Ql + t * PT + lq * 16;
#pragma unroll
        for (int et = 0; et < 8; ++et) { const LAS unsigned char* paS = Sl + (16 * et + l15) * PT + lq * 16;
            f32x4 ai = (f32x4){0.f, 0.f, 0.f, 0.f};
#pragma unroll
            for (int s = 0; s < 4; ++s) ai = __builtin_amdgcn_mfma_f32_16x16x32_bf16(ld_tr_frag(Kl, PT, 32 * s, 16 * et, lane), *(const LAS bf16x8*)(pbP + s * 64), ai, 0, 0, 0);
            const f32x4 ac = mma_k<4>(paS, pbQ, (f32x4){0.f, 0.f, 0.f, 0.f});
            o[hf * 8 + et] = ai + ac * qw; }
        lds_barrier();
    }
    if (u_next >= 0) ret_load(RR, P, u_next, tid);
    float sum = 0.f;
#pragma unroll
    for (int i = 0; i < 16; ++i) sum += (o[i][0] + o[i][1]) + (o[i][2] + o[i][3]);
    sum += __shfl_xor(sum, 16); sum += __shfl_xor(sum, 32);
    const float mean = sum * (1.0f / 256.0f); float var = 0.f;
#pragma unroll
    for (int i = 0; i < 16; ++i) { const f32x4 dd = o[i] - mean; var += (dd[0] * dd[0] + dd[1] * dd[1]) + (dd[2] * dd[2] + dd[3] * dd[3]); }
    var += __shfl_xor(var, 16); var += __shfl_xor(var, 32);
    const float rstd = rsqrtf(var * (1.0f / 256.0f) + GN_EPS);
#pragma unroll
    for (int i = 0; i < 16; ++i) { const int e = 16 * i + 4 * lq; bf16_t* gp = P + (row0 + t) * PW + C_CG + h * 256 + e; const u32x2 gv = *((const u32x2*)gp); const f32x4 gg = *(const f32x4*)(gn + h * 256 + e);
        u32x2 w; w.x = pk2((o[i][0] - mean) * rstd * gg[0] * bflo(gv.x), (o[i][1] - mean) * rstd * gg[1] * bfhi(gv.x));
        w.y = pk2((o[i][2] - mean) * rstd * gg[2] * bflo(gv.y), (o[i][3] - mean) * rstd * gg[3] * bfhi(gv.y));
        *(u32x2*)gp = w; if ((i & 7) == 7) asm volatile("" ::: "memory"); }
    lds_barrier();
}

__device__ __forceinline__ void transpose_item(const float* W, int K, int N, bf16_t* WT, const float* gk, bool swiglu, LAS float* scr, int item, int lane) {
    const int nblk = N / 64, kb = item / nblk, nb = item % nblk, k0 = 64 * kb, n0 = 64 * nb;
    const int kr = lane >> 4, nq = 4 * (lane & 15);
    f32x4 v[16];
#pragma unroll
    for (int i = 0; i < 16; ++i) v[i] = *(const f32x4*)(W + (size_t)(k0 + 4 * i + kr) * N + n0 + nq);
#pragma unroll
    for (int i = 0; i < 16; ++i) { const int kk = 4 * i + kr; const float g = gk ? gk[k0 + kk] : 1.0f; LAS float* d = scr + kk * 65 + nq;
        d[0] = v[i][0] * g; d[1] = v[i][1] * g; d[2] = v[i][2] * g; d[3] = v[i][3] * g; }
    asm volatile("s_waitcnt lgkmcnt(0)" ::: "memory");
    int d0 = n0; if (swiglu) { const int bj = n0 / F, rem = n0 % F; d0 = 256 * (rem / 128) + 128 * bj + (rem % 128); }
    const int c = lane & 7;
#pragma unroll
    for (int j = 0; j < 8; ++j) { const int n = (lane >> 3) + 8 * j; const LAS float* s = scr + (8 * c) * 65 + n;
        u32x4 o; o.x = pk2(s[0 * 65], s[1 * 65]); o.y = pk2(s[2 * 65], s[3 * 65]); o.z = pk2(s[4 * 65], s[5 * 65]); o.w = pk2(s[6 * 65], s[7 * 65]);
        *(u32x4*)(WT + (size_t)(d0 + n) * K + k0 + 8 * c) = o; }
    asm volatile("s_waitcnt lgkmcnt(0)" ::: "memory");
}

#define XB_TMO      128
#define XB_XCNT(j)  (256  + 64 * (j))
#define XB_XSUB(j)  (1280 + 64 * (j))
#define XB_XGEN(j)  (2304 + 64 * (j))
#define XB_TOP      3328
#define XB_TOPGEN   3392
#define XCD_BAR_WORDS 3456
#define XB_SPIN_CAP (1u << 18)
__device__ __forceinline__ unsigned xb_ld(unsigned* p)              { return __hip_atomic_load(p, __ATOMIC_RELAXED, __HIP_MEMORY_SCOPE_AGENT); }
__device__ __forceinline__ unsigned xb_add(unsigned* p, unsigned v) { return __hip_atomic_fetch_add(p, v, __ATOMIC_RELAXED, __HIP_MEMORY_SCOPE_AGENT); }
__device__ __forceinline__ unsigned xb_xcc_id() { return (unsigned)__builtin_amdgcn_s_getreg((3 << 11) | 20) & 0xFu; }
#define XB_SPIN(cond, bar) do { unsigned _sp = 0; while (cond) { __builtin_amdgcn_s_sleep(1); \
    if ((++_sp & 255u) == 0u) { if (xb_ld(&(bar)[XB_TMO])) break; if (_sp > XB_SPIN_CAP) { atomicAdd(&(bar)[XB_TMO], 1u); break; } } } } while (0)
struct XcdBarrier { unsigned* bar; unsigned x; volatile LAS unsigned* st; };
__device__ __forceinline__ XcdBarrier xcd_barrier_post(unsigned* bar, volatile LAS unsigned* st) {
    XcdBarrier b; b.bar = bar; b.x = xb_xcc_id(); b.st = st;
    if (threadIdx.x == 0) (void)xb_add(&bar[XB_XCNT(b.x)], 1u);
    return b;
}
__device__ __forceinline__ void xcd_barrier_complete(unsigned* bar, unsigned x, unsigned& nloc, unsigned& nx) {
    const unsigned G = gridDim.x * gridDim.y * gridDim.z;
    unsigned sum, cnt, mine, sp = 0u;
    for (;;) {
        sum = 0u; cnt = 0u; mine = 0u;
#pragma unroll
        for (unsigned j = 0; j < 16; ++j) { const unsigned c = xb_ld(&bar[XB_XCNT(j)]); sum += c; cnt += (c > 0u) ? 1u : 0u; mine = (j == x) ? c : mine; }
        if (sum == G) break;
        __builtin_amdgcn_s_sleep(1);
        if ((++sp & 255u) == 0u) { if (xb_ld(&bar[XB_TMO])) break; if (sp > XB_SPIN_CAP) { atomicAdd(&bar[XB_TMO], 1u); break; } }
    }
    nloc = mine > 0u ? mine : 1u; nx = cnt > 0u ? cnt : 1u;
}
__device__ __forceinline__ void xcd_barrier(const XcdBarrier& b) {
    asm volatile("s_waitcnt vmcnt(0)" ::: "memory");
    __syncthreads();
    if (threadIdx.x == 0) {
        unsigned* bar = b.bar;
        __builtin_amdgcn_s_waitcnt(0);
        unsigned nloc = b.st[0], nx = b.st[1];
        if (nloc == 0u) { xcd_barrier_complete(bar, b.x, nloc, nx); b.st[0] = nloc; b.st[1] = nx; }
        const unsigned old = xb_add(&bar[XB_XSUB(b.x)], 1u);
        const unsigned gen = old / nloc;
        if (old + 1u == (gen + 1u) * nloc) {
            __builtin_amdgcn_fence(__ATOMIC_RELEASE, "agent");
            asm volatile("s_waitcnt vmcnt(0)" ::: "memory");
            const unsigned og = xb_add(&bar[XB_TOP], 1u);
            const unsigned tg = og / nx;
            if (og + 1u == (tg + 1u) * nx) xb_add(&bar[XB_TOPGEN], 1u);
            else XB_SPIN(xb_ld(&bar[XB_TOPGEN]) == tg, bar);
            __builtin_amdgcn_fence(__ATOMIC_ACQUIRE, "agent");
            xb_add(&bar[XB_XGEN(b.x)], 1u);
            asm volatile("s_waitcnt vmcnt(0)" ::: "memory");
        } else {
            XB_SPIN(xb_ld(&bar[XB_XGEN(b.x)]) == gen, bar);
            __builtin_amdgcn_fence(__ATOMIC_ACQUIRE, "agent");
            asm volatile("s_waitcnt vmcnt(0)" ::: "memory");
        }
    }
    __syncthreads();
}

struct Args { const float* in[20]; float* out; unsigned char* ws; int ph_lo, ph_hi; };

constexpr int LDS_BYTES = 147456;

__global__ void __launch_bounds__(512, 2) mk_fwd(Args a) {
    extern __shared__ __attribute__((aligned(16))) unsigned char lds_raw[];
    LAS unsigned char* L = (LAS unsigned char*)lds_raw;
    volatile LAS unsigned* xst = (volatile LAS unsigned*)(L + 131072 + 8192);
    if (threadIdx.x == 0) { xst[0] = 0u; xst[1] = 0u; }
    __syncthreads();
    const XcdBarrier xbar = xcd_barrier_post((unsigned*)(a.ws + WS_BAR), xst);
#ifndef MK_STOP
#define MK_STOP NPHASES
#endif
    for (int pidx = a.ph_lo; pidx < a.ph_hi; ++pidx) {
        const int ph = (MK_REPBLK) ? ((pidx > 6) ? pidx - 4 : pidx) : (MK_REPPH >= 0) ? ((pidx > MK_REPPH) ? pidx - 1 : pidx) : ((!MK_MULTI && MK_STOP < NPHASES && pidx == a.ph_hi - 1) ? NPHASES - 1 : pidx);
        int tid = threadIdx.x; asm volatile("" : "+v"(tid));
        int bid = blockIdx.x; asm volatile("" : "+s"(bid));
        unsigned char* ws = a.ws; asm volatile("" : "+s"(ws));
        const int lane = tid & 63, wave = __builtin_amdgcn_readfirstlane(tid >> 6);
        const int G = gridDim.x;
        float* SS = (float*)(ws + WS_SSP);
        bf16_t* WB = (bf16_t*)(ws + WS_WB);
        bf16_t* XB = (bf16_t*)(ws + WS_XB);
        bf16_t* KV = (bf16_t*)(ws + WS_KV);
        bf16_t* P = (bf16_t*)(ws + WS_P);
        bf16_t* H = P;
        float* OUT = a.out;
        const int l = ph / NPH_LAYER, k0 = (ph == NPHASES - 1) ? 99 : ph % NPH_LAYER;
        const bool inmix = (k0 >= 3 && k0 < 3 + 6 * NB);
        const int bsel = inmix ? (k0 - 3) / 6 : 0;
        const int k = inmix ? 3 + (k0 - 3) % 6 : (k0 == 3 + 6 * NB ? 15 : (k0 == 4 + 6 * NB ? 16 : k0));
        const size_t rowoff = (size_t)bsel * MH;
#if MK_GOVL || MK_NB == 1
        bf16_t* Gt = P + C_GT; bf16_t* Mg = P + C_MG; const int ldg = PW;
#else
        bf16_t* Gt = (bf16_t*)(ws + WS_G) + rowoff * D; bf16_t* Mg = (bf16_t*)(ws + WS_MG) + rowoff * D; const int ldg = D;
#endif
        if (k == 0) {
            int lane_o = lane; asm volatile("" : "+v"(lane_o));
            LAS float* scr = (LAS float*)(L + wave * 16640);
            const int gw = bid * 8 + wave, NGW = G * 8;
            for (int it = gw; it < 6976; it += NGW) {
                int r = it; const float* W; const float* gk = nullptr; bf16_t* WT; int K_, N_; bool sw = false;
                if (r < 1408) { W = a.in[2] + (size_t)l * D * 2 * F; K_ = D; N_ = 2 * F; WT = WB + O_W1IN; gk = a.in[1] + l * D; sw = true; }
                else if ((r -= 1408) < 704) { W = a.in[3] + (size_t)l * F * D; K_ = F; N_ = D; WT = WB + O_W1OUT; }
                else if ((r -= 704) < 1984) { W = a.in[5] + (size_t)l * D * 7936; K_ = D; N_ = 7936; WT = WB + O_WIN; gk = a.in[4] + l * D; }
                else if ((r -= 1984) < 128) { W = a.in[12] + (size_t)l * 512 * D; K_ = 512; N_ = D; WT = WB + O_WBA; }
                else if ((r -= 128) < 128) { W = a.in[13] + (size_t)l * 512 * D; K_ = 512; N_ = D; WT = WB + O_WBB; }
                else if ((r -= 128) < 256) { W = a.in[14] + (size_t)l * D * D; K_ = D; N_ = D; WT = WB + O_WBC; }
                else if ((r -= 256) < 256) { W = a.in[15] + (size_t)l * D * D; K_ = D; N_ = D; WT = WB + O_WOUT; }
                else if ((r -= 256) < 1408) { W = a.in[17] + (size_t)l * D * 2 * F; K_ = D; N_ = 2 * F; WT = WB + O_W2IN; gk = a.in[16] + l * D; sw = true; }
                else { r -= 1408; W = a.in[18] + (size_t)l * F * D; K_ = F; N_ = D; WT = WB + O_W2OUT; }
                transpose_item(W, K_, N_, WT, gk, sw, scr, r, lane_o);
            }
            {
                const float* wsrc = a.in[8] + (size_t)l * 65536;
                for (int i = bid * 512 + tid; i < 65536; i += G * 512) { const int tt = (i >> 7) & 127, s = i & 127; WB[O_WS + i] = (bf16_t)f2bf(s <= tt ? wsrc[i] : 0.f); }
            }
            if (l == 0) {
                const float* x = a.in[0];
                for (int m = gw; m < M; m += NGW) { const f32x4* xr = (const f32x4*)(x + (size_t)m * D) + lane; float s = 0.f; u32x2* o8 = (u32x2*)(XB + (size_t)m * D) + lane;
#pragma unroll
                    for (int j = 0; j < 4; ++j) { const f32x4 v = xr[64 * j]; s += (v[0] * v[0] + v[1] * v[1]) + (v[2] * v[2] + v[3] * v[3]); u32x2 w; w.x = pk2(v[0], v[1]); w.y = pk2(v[2], v[3]); o8[64 * j] = w; }
#pragma unroll
                    for (int o = 1; o < 64; o <<= 1) s += __shfl_xor(s, o);
                    if (lane == 0) *(f32x4*)(SS + (size_t)m * 4) = (f32x4){s, 0.f, 0.f, 0.f}; }
            }
            __syncthreads();
        } else if (k == 1 || k == 15) {
            pg8::Gemm g{XB, WB + (k == 1 ? O_W1IN : O_W2IN), M, 2 * F, D, D}; pg8::StaticOrder S; S.init(M, 2 * F, G, bid);
            pg8::EpiSwiglu E{H, SS + (size_t)(3 * l + (k == 1 ? 0 : 2)) * M * 4};
            pg8::gemm_phase<pg8::EpiSwiglu>(L, g, S, E);
        } else if (k == 2 || k == 16) {
            pg8::Gemm g{H, WB + (k == 2 ? O_W1OUT : O_W2OUT), M, D, F, F}; pg8::StaticOrder S; S.init(M, D, G, bid);
            const int sidx = 3 * l + (k == 2 ? 1 : 3);
            pg8::EpiResid E{(l == 0 && k == 2) ? a.in[0] : nullptr, XB, SS + (size_t)sidx * M * 4, 0.5f, (LAS float*)(L + 131072)};
            pg8::gemm_phase<pg8::EpiResid>(L, g, S, E);
        } else if (k == 8) {
            pg8::Gemm g{Mg, WB + O_WOUT, MH, D, D, ldg}; pg8::StaticOrder S; S.init(MH, D, G, bid);
            pg8::EpiResid E{nullptr, XB + rowoff * D, SS + (size_t)(3 * l + 2) * M * 4 + rowoff * 4, 1.0f, (LAS float*)(L + 131072)};
            pg8::gemm_phase<pg8::EpiResid>(L, g, S, E);
        } else if (k == 3) {
            pg8::Gemm g{XB + rowoff * D, WB + O_WIN, MH, PW, D, D}; pg8::StaticOrder S; S.init(MH, PW, G, bid);
            pg8::EpiInproj E{P, SS + (size_t)(3 * l + 1) * M * 4 + rowoff * 4};
            pg8::gemm_phase<pg8::EpiInproj>(L, g, S, E);
        } else if (k == 4) {
            int i = bid;
            for (; i < 2 * NCH; i += G) {
                if (i < NCH) unit_attn(L, P, a.in[10] + l * 8, i, tid);
                else unit_gmlp(L, P, WB + O_WS, a.in[7] + l * 512, a.in[9] + l * 512, i - NCH, tid);
            }
            if (i < 6 * NCH) {
                int tk = tid; asm volatile("" : "+v"(tk));
                KvRegs R; kv_load(R, P, i - 2 * NCH, tk);
                for (; i < 6 * NCH; i += G) { const int u = i - 2 * NCH;
                    kv_store(L, R, u, tk); lds_barrier();
                    if (i + G < 6 * NCH) kv_load(R, P, i + G - 2 * NCH, tk);
                    kv_compute(L, KV, u, tk); lds_barrier(); }
            }
        } else if (k == 5) {
            phase_scan(KV, bid * 512 + tid, G * 512);
        } else if (k == 6) {
            if (bid < 4 * NCH) { int tk = tid; asm volatile("" : "+v"(tk)); RetRegs R; ret_load(R, P, bid, tk);
                for (int i = bid; i < 4 * NCH; i += G) unit_ret(L, P, KV, a.in[11] + l * 1024, i, tid, R, (i + G < 4 * NCH) ? i + G : -1); }
        } else if (k == 7) {
            for (int br = 0; br < 3; ++br) {
                const int gi = (br == 0) ? 2 : (br - 1);
                if (2 * br >= MK_P7) break;
                {   pg8::Gemm g{XB + rowoff * D, WB + O_WIN + (size_t)(PW + gi * D) * D, MH, D, D, D}; pg8::StaticOrder S; S.init(MH, D, G, bid);
                    pg8::EpiGate E{Gt, SS + (size_t)(3 * l + 1) * M * 4 + rowoff * 4, a.in[6] + l * 3 * D + gi * D, ldg, (MK_X2) ? OUT + rowoff * D : nullptr};
                    pg8::gemm_phase<pg8::EpiGate>(L, g, S, E);
#if MK_T10
                    {
                        asm volatile("s_waitcnt vmcnt(0)" ::: "memory"); __syncthreads();
                        pg8::Unit uu; for (int ui = 0; S.next(ui, uu); ++ui)
                            for (int e = tid; e < 256 * 256; e += 512) { const int r = e >> 8, c = e & 255; const size_t row = (size_t)uu.pm * 256 + r, col = (size_t)uu.pn * 256 + c;
                                OUT[(rowoff + row) * D + col] = bflo((unsigned)Gt[row * ldg + col]); }
                    }
#endif
                }
                if (2 * br + 1 >= MK_P7) break;
                {   pg8::Gemm g; pg8::StaticOrder S; S.init(MH, D, G, bid);
                    if (br == 0) g = pg8::Gemm{P + C_CG, WB + O_WBC, MH, D, D, PW}; else if (br == 1) g = pg8::Gemm{P + C_AU, WB + O_WBA, MH, D, 512, PW}; else g = pg8::Gemm{P + C_BQ, WB + O_WBB, MH, D, 512, PW};
                    pg8::EpiMerge E{Gt, Mg, br == 0 ? 1 : 0, ldg};
                    pg8::gemm_phase<pg8::EpiMerge>(L, g, S, E); }
            }
        } else {
#if MK_X2 || MK_T10
            continue;
#endif
#ifdef MK_DBG
#if MK_DELAY
            { const unsigned long long t0 = __builtin_amdgcn_s_memrealtime(); while (__builtin_amdgcn_s_memrealtime() - t0 < 30000ull) __builtin_amdgcn_s_sleep(32); }
            __builtin_amdgcn_fence(__ATOMIC_ACQUIRE, "agent"); asm volatile("s_waitcnt vmcnt(0)" ::: "memory"); __syncthreads();
#endif
            {   const bf16_t* src16 = (MK_DBG == 1) ? Gt : Mg;
                for (size_t i = (size_t)bid * 512 + tid; i < (size_t)M * D; i += (size_t)G * 512) { const size_t m = i >> 10, c = i & 1023; OUT[i] = (m < (size_t)MH) ? bflo((unsigned)src16[m * ldg + c]) : 0.f; } }
            continue;
#endif
            const int gw = bid * 8 + wave, NGW = G * 8; const float* fg = a.in[19]; const float* ss = SS + (size_t)6 * M * 4;
            for (int m = gw; m < M; m += NGW) { f32x4* xr = (f32x4*)(OUT + (size_t)m * D) + lane; const u32x2* xs = (const u32x2*)(XB + (size_t)m * D) + lane; const float r = row_rstd(ss, m);
#pragma unroll
                for (int j = 0; j < 4; ++j) { const u32x2 bw = xs[64 * j]; const f32x4 v = (f32x4){bflo(bw.x), bfhi(bw.x), bflo(bw.y), bfhi(bw.y)}; const f32x4 gq = *((const f32x4*)fg + lane + 64 * j); xr[64 * j] = v * r * gq; } }
        }
        if (pidx + 1 < a.ph_hi) {
            xcd_barrier(xbar);
            if (pidx == a.ph_lo) { asm volatile("s_waitcnt vmcnt(0) lgkmcnt(0)" ::: "memory"); __syncthreads(); cg::this_grid().sync();
                __builtin_amdgcn_fence(__ATOMIC_ACQUIRE, "agent"); asm volatile("s_waitcnt vmcnt(0)" ::: "memory"); __syncthreads(); }
        }
    }
}

extern "C" void kernel_launch(void* const* d_in, const int* in_sizes, int n_in, void* d_out, int out_size, void* d_ws, size_t ws_size, hipStream_t stream) {
    static int grid = 0;
    if (grid == 0) {
        if (n_in != 20 || in_sizes[0] != M * D || out_size != M * D || ws_size < WS_END) { fprintf(stderr, "kernel_launch: unexpected shapes / workspace (n_in %d, ws %zu, need %zu)\n", n_in, ws_size, (size_t)WS_END); grid = -1; return; }
        int dev = 0, cus = 0, per_cu = 0;
        hipGetDevice(&dev); hipDeviceGetAttribute(&cus, hipDeviceAttributeMultiprocessorCount, dev);
        if (hipFuncSetAttribute((const void*)mk_fwd, hipFuncAttributeMaxDynamicSharedMemorySize, LDS_BYTES) != hipSuccess) { fprintf(stderr, "kernel_launch: hipFuncSetAttribute failed\n"); grid = -1; return; }
        if (hipOccupancyMaxActiveBlocksPerMultiprocessor(&per_cu, (const void*)mk_fwd, 512, LDS_BYTES) != hipSuccess || per_cu < 1) { fprintf(stderr, "kernel_launch: occupancy query says %d\n", per_cu); per_cu = 1; }
        (void)hipGetLastError();
        grid = cus * 1;
    }
    if (grid < 0) return;
    (void)hipMemsetAsync((char*)d_ws + WS_BAR, 0, 16384, stream);
    Args a{};
    for (int i = 0; i < 20; ++i) a.in[i] = (const float*)d_in[i];
    a.out = (float*)d_out; a.ws = (unsigned char*)d_ws;
#if MK_MULTI
    for (int i = 0; i < ((MK_STOP < NPHASES) ? MK_STOP + 1 : NPHASES); ++i) { const int ph = (MK_STOP < NPHASES && i == MK_STOP) ? NPHASES - 1 : i; a.ph_lo = ph; a.ph_hi = ph + 1; hipLaunchKernelGGL(mk_fwd, dim3(grid), dim3(512), LDS_BYTES, stream, a); }
#else
    a.ph_lo = 0; a.ph_hi = (MK_REPBLK) ? NPHASES + 4 : (MK_REPPH >= 0) ? NPHASES + 1 : ((MK_STOP < NPHASES) ? MK_STOP + 1 : NPHASES);
    void* args[] = {&a};
    hipError_t e = hipLaunchCooperativeKernel((const void*)mk_fwd, dim3(grid), dim3(512), args, LDS_BYTES, stream);
    if (e != hipSuccess) fprintf(stderr, "cooperative launch failed: %s (grid %d)\n", hipGetErrorString(e), grid);
#endif
}
```

```cpp
#include <hip/hip_runtime.h>
#include <hip/hip_cooperative_groups.h>
#include <cstdio>
#include <cstdint>
namespace cg = cooperative_groups;

#ifndef MK_DELAY
#define MK_DELAY 0
#endif
#define MK_WTG 0
#define MK_T10 0
#ifndef MK_EXTRASYNC
#define MK_EXTRASYNC 0
#endif
#ifndef MK_REPPH
#define MK_REPPH -1
#endif
#ifndef MK_FENCE
#define MK_FENCE 4
#endif
#ifndef MK_REPBLK
#define MK_REPBLK 0
#endif
#ifndef MK_GOVL
#define MK_GOVL 0
#endif
#ifndef MK_SCRUB
#define MK_SCRUB 0
#endif
#ifndef MK_WTIN
#define MK_WTIN 0
#endif
#ifndef MK_X3
#define MK_X3 0
#endif
#ifndef MK_X2
#define MK_X2 0
#endif
#ifndef MK_P7
#define MK_P7 6
#endif
#ifndef MK_CGSYNC
#define MK_CGSYNC 0
#endif
#ifndef MK_MULTI
#define MK_MULTI 0
#endif

#define LAS __attribute__((address_space(3)))
typedef unsigned short bf16_t;
typedef short bf16x8 __attribute__((ext_vector_type(8)));
typedef float f32x4 __attribute__((ext_vector_type(4)));
typedef float f32x2 __attribute__((ext_vector_type(2)));
typedef unsigned u32x4 __attribute__((ext_vector_type(4)));
typedef unsigned u32x2 __attribute__((ext_vector_type(2)));

constexpr int M = 32768, D = 1024, F = 2816, NCHUNK = 256, DEPTH = 2;
constexpr int PW = 4864;
constexpr int C_AU = 0, C_AV = 512, C_BQ = 1024, C_BK = 1536, C_BV = 1664, C_CQ = 1792, C_CK = 2304, C_CV = 2816, C_CG = 3840;
constexpr int C_GT = 1792;
constexpr int C_MG = 2816;
constexpr float NORM_EPS = 1e-6f, GN_EPS = 1e-5f, LOG2E = 1.4426950408889634f;
#ifndef MK_NB
#define MK_NB 1
#endif
constexpr int NB = MK_NB;
constexpr int MH = M / NB, NCH = MH / 128;
constexpr int NPH_LAYER = 5 + 6 * NB, NPHASES = NPH_LAYER * DEPTH + 1;

constexpr size_t MiB = 1u << 20;
constexpr size_t WS_BAR = 0;
constexpr size_t WS_WB = 1 * MiB;
constexpr size_t WS_XB = 57 * MiB;
constexpr size_t WS_P = 121 * MiB;
constexpr size_t WS_KV = WS_P + (size_t)MH * PW * 2;
constexpr size_t WS_G = WS_KV + (size_t)MH * 2048;
constexpr size_t WS_MG = WS_G + (NB == 2 ? 64 * MiB : 0);
constexpr size_t WS_SSP = WS_MG + (NB == 2 ? 64 * MiB : 0);
constexpr size_t WS_END = WS_SSP + 4 * MiB;
static_assert(WS_END <= 512 * MiB && WS_P + (size_t)M * F * 2 <= WS_G, "d_ws map");
constexpr size_t O_W1IN = 0, O_W1OUT = 5767168, O_WIN = 8650752, O_WBA = 16777216, O_WBB = 17301504, O_WBC = 17825792,
                 O_WOUT = 18874368, O_W2IN = 19922944, O_W2OUT = 25690112, O_WS = 28573696, O_WEND = 28639232;
static_assert(O_WEND * 2 <= 56 * MiB, "weights fit");

__device__ __forceinline__ float bflo(unsigned w) { return __uint_as_float(w << 16); }
__device__ __forceinline__ float bfhi(unsigned w) { return __uint_as_float(w & 0xffff0000u); }
__device__ __forceinline__ unsigned f2bf(float f) { unsigned u = __float_as_uint(f); return (u + 0x7fffu + ((u >> 16) & 1u)) >> 16; }
__device__ __forceinline__ unsigned pk2(float lo, float hi) { return f2bf(lo) | (f2bf(hi) << 16); }
__device__ __forceinline__ float fexp2(float x) { return __builtin_amdgcn_exp2f(x); }
__device__ __forceinline__ float frcp(float x) { return __builtin_amdgcn_rcpf(x); }
__device__ __forceinline__ float sigmoid_f(float x) { return frcp(1.0f + fexp2(-x * LOG2E)); }
__device__ __forceinline__ float silu_f(float x) { return x * sigmoid_f(x); }
__device__ __forceinline__ float gelu_tanh_f(float x) { const float u = 0.7978845608028654f * (x + 0.044715f * x * x * x); return x * frcp(1.0f + fexp2(-2.0f * LOG2E * u)); }

__device__ __forceinline__ void st16_wt(void* p, u32x4 v) { asm volatile("global_store_dwordx4 %0, %1, off sc0 sc1" :: "v"(p), "v"(v) : "memory"); }
__device__ __forceinline__ void st8_wt(void* p, u32x2 v) { asm volatile("global_store_dwordx2 %0, %1, off sc0 sc1" :: "v"(p), "v"(v) : "memory"); }
__device__ __forceinline__ void st4_wt(void* p, float v) { asm volatile("global_store_dword %0, %1, off sc0 sc1" :: "v"(p), "v"(v) : "memory"); }
__device__ __forceinline__ float row_rstd(const float* ssp, int row) { const f32x4 p = *(const f32x4*)(ssp + (size_t)row * 4); return rsqrtf(((p[0] + p[1]) + (p[2] + p[3])) * (1.0f / D) + NORM_EPS); }

namespace pg8 {
constexpr int BM = 256, BK = 64, HALF = 128, HTB = HALF * BK * 2, STAGE_BYTES = 8 * HTB, NXCD = 8, WGM = 8;
__host__ __device__ __forceinline__ int lds_byte(int r, int c) { const int st = (r >> 4) * 2 + (c >> 5), rr = r & 15, cc = c & 31, ob = rr * 64 + cc * 2; return st * 1024 + (ob ^ (((ob >> 9) & 1) << 5)); }
__host__ __device__ __forceinline__ void stage_rc(int b, int& R, int& C) { const int st = b / 1024, sb = b % 1024, swz = sb ^ (((sb >> 9) & 1) << 5); R = (st >> 1) * 16 + swz / 64; C = (st & 1) * 32 + (swz % 64) / 2; }
__host__ __device__ __forceinline__ int perm32(int rho) { const int n = rho >> 4, i = rho & 15; return 8 * (i >> 2) + 4 * n + (i & 3); }

struct Unit { int pm, pn; };
struct Gemm { const bf16_t* A; const bf16_t* Bt; int M, N, K, lda; };

struct StaticOrder {
    int nM, nN, nwg, G, c;
    __device__ void init(int M_, int N_, int G_, int c_) { nM = M_ / BM; nN = N_ / BM; nwg = nM * nN; G = G_; c = c_; }
    __device__ bool next(int i, Unit& u) const {
        const long L = (long)i * G + c; if (L >= nwg) return false;
        int wgid = (int)L; { const int q = nwg / NXCD, r = nwg % NXCD, xcd = wgid % NXCD, off = wgid / NXCD; wgid = (xcd < r ? xcd * (q + 1) : r * (q + 1) + (xcd - r) * q) + off; }
        const int nig = WGM * nN, gid = wgid / nig, fm = gid * WGM, gsz = (nM - fm) < WGM ? (nM - fm) : WGM;
        u.pm = fm + ((wgid % nig) % gsz); u.pn = (wgid % nig) / gsz; return true;
    }
};
typedef __bf16 bf16x2_t __attribute__((ext_vector_type(2)));
__device__ __forceinline__ unsigned cvt_pk_bf16(float lo, float hi) { const f32x2 v = {lo, hi}; const bf16x2_t b = __builtin_convertvector(v, bf16x2_t); return __builtin_bit_cast(unsigned, b); }

template <class Epi>
__device__ __forceinline__ void gemm_phase(LAS unsigned char* lds, const Gemm g, const StaticOrder& S, const Epi& E) {
    int tid = threadIdx.x; asm volatile("" : "+v"(tid));
    const int wid = __builtin_amdgcn_readfirstlane(tid >> 6), lane = tid & 63, wr = wid >> 2, wc = wid & 3, fr = lane & 15, fq = lane >> 4;
    const int K = g.K, nt = K / BK, lda = g.lda;
    unsigned voffA[2], voffB[2];
#pragma unroll
    for (int i = 0; i < 2; ++i) { int R, C; stage_rc(tid * 16 + i * 8192, R, C); const int Rb = Epi::PERM ? ((R & ~31) + perm32(R & 31)) : R;
        voffA[i] = (unsigned)(R * lda + C) * 2u; voffB[i] = (unsigned)(Rb * K + C) * 2u; }
    const size_t kstep = (size_t)(BK * 2);
    const size_t hstepA = (size_t)HALF * lda * 2, hstepB = (size_t)HALF * K * 2;
    const size_t tstepA = 2 * hstepA, tstepB = 2 * hstepB;
    const unsigned ldsw = (unsigned)wid * 1024u;
    const int aoff = lds_byte(wr * 64 + fr, fq * 8), boff = lds_byte(wc * 32 + fr, fq * 8);
#define PG8_SA(b, h) (((b) * 2 + (h)) * HTB)
#define PG8_SB(b, h) ((4 + (b) * 2 + (h)) * HTB)
#define PG8_STAGE(bufoff, gbase, voff) do { _Pragma("unroll") for (int _i = 0; _i < 2; ++_i) \
        __builtin_amdgcn_global_load_lds((const unsigned*)((const char*)(gbase) + (voff)[_i]), (LAS unsigned*)(lds + (bufoff) + ldsw + _i * 8192), 16, 0, 0); } while (0)
#define PG8_LDA(dst, b, h) do { _Pragma("unroll") for (int m = 0; m < 4; ++m) _Pragma("unroll") for (int k = 0; k < 2; ++k) dst[m][k] = *(const LAS bf16x8*)(lds + PG8_SA(b, h) + aoff + m * 2048 + k * 1024); } while (0)
#define PG8_LDB(dst, b, h) do { _Pragma("unroll") for (int n = 0; n < 2; ++n) _Pragma("unroll") for (int k = 0; k < 2; ++k) dst[n][k] = *(const LAS bf16x8*)(lds + PG8_SB(b, h) + boff + n * 2048 + k * 1024); } while (0)
#define PG8_MMA(ai, bj, At, Bt) do { __builtin_amdgcn_s_setprio(1); _Pragma("unroll") for (int m = 0; m < 4; ++m) _Pragma("unroll") for (int n = 0; n < 2; ++n) _Pragma("unroll") for (int k = 0; k < 2; ++k) \
        acc[ai][bj][m][n] = __builtin_amdgcn_mfma_f32_16x16x32_bf16(Bt[n][k], At[m][k], acc[ai][bj][m][n], 0, 0, 0); __builtin_amdgcn_s_setprio(0); } while (0)
#define PG8_WAIT_V(n) asm volatile("s_waitcnt vmcnt(" #n ")" ::: "memory")
#define PG8_WAIT_L(n) asm volatile("s_waitcnt lgkmcnt(" #n ")" ::: "memory")
#define PG8_BAR __builtin_amdgcn_s_barrier()
#define PG8_SCHED __builtin_amdgcn_sched_barrier(0)
    Unit cur, nxt; int ui = 0;
    if (!S.next(0, cur)) return;
    f32x4 acc[2][2][4][2];
#pragma unroll
    for (int a = 0; a < 2; ++a)
#pragma unroll
        for (int b = 0; b < 2; ++b)
#pragma unroll
            for (int m = 0; m < 4; ++m)
#pragma unroll
                for (int n = 0; n < 2; ++n) acc[a][b][m][n] = (f32x4){0.f, 0.f, 0.f, 0.f};
    bf16x8 At[4][2], B0[2][2], B1[2][2];
    const char* cA = (const char*)g.A + (size_t)cur.pm * tstepA; const char* cB = (const char*)g.Bt + (size_t)cur.pn * tstepB;
    PG8_STAGE(PG8_SB(0, 0), cB, voffB); PG8_STAGE(PG8_SB(0, 1), cB + hstepB, voffB); PG8_STAGE(PG8_SA(0, 0), cA, voffA); PG8_STAGE(PG8_SA(0, 1), cA + hstepA, voffA);
    if (wr == 1) PG8_BAR;
    PG8_WAIT_V(2); PG8_BAR;
    PG8_STAGE(PG8_SB(1, 0), cB + kstep, voffB); PG8_STAGE(PG8_SA(1, 0), cA + kstep, voffA); PG8_STAGE(PG8_SB(1, 1), cB + hstepB + kstep, voffB);
    PG8_WAIT_V(6); PG8_BAR;
    for (;;) {
        const bool has_next = S.next(ui + 1, nxt);
        const char* nA = has_next ? (const char*)g.A + (size_t)nxt.pm * tstepA : cA; const char* nB = has_next ? (const char*)g.Bt + (size_t)nxt.pn * tstepB : cB;
        for (int t = 0; t < nt; t += 2) {
            const bool last = (t == nt - 2);
            const char* a1 = cA + (size_t)(t + 1) * kstep;
            const char* a2 = last ? nA : cA + (size_t)(t + 2) * kstep; const char* b2 = last ? nB : cB + (size_t)(t + 2) * kstep;
            const char* a3 = a2 + kstep; const char* b3 = b2 + kstep;
            PG8_LDB(B0, 0, 0); PG8_LDB(B1, 0, 1); PG8_SCHED; PG8_LDA(At, 0, 0); PG8_STAGE(PG8_SA(1, 1), a1 + hstepA, voffA);
            PG8_WAIT_V(8); PG8_WAIT_L(0); PG8_BAR; PG8_MMA(0, 0, At, B0); PG8_MMA(0, 1, At, B1); PG8_BAR; PG8_SCHED;
            PG8_LDA(At, 0, 1); PG8_STAGE(PG8_SB(0, 0), b2, voffB); PG8_STAGE(PG8_SB(0, 1), b2 + hstepB, voffB); PG8_STAGE(PG8_SA(0, 0), a2, voffA);
            PG8_WAIT_V(8); PG8_WAIT_L(0); PG8_BAR; PG8_MMA(1, 0, At, B0); PG8_MMA(1, 1, At, B1); PG8_BAR; PG8_SCHED;
            PG8_LDB(B0, 1, 0); PG8_LDB(B1, 1, 1); PG8_SCHED; PG8_LDA(At, 1, 0); PG8_STAGE(PG8_SA(0, 1), a2 + hstepA, voffA);
            PG8_WAIT_V(8); PG8_WAIT_L(0); PG8_BAR; PG8_MMA(0, 0, At, B0); PG8_MMA(0, 1, At, B1); PG8_BAR; PG8_SCHED;
            PG8_LDA(At, 1, 1); PG8_STAGE(PG8_SB(1, 0), b3, voffB); PG8_STAGE(PG8_SB(1, 1), b3 + hstepB, voffB); PG8_STAGE(PG8_SA(1, 0), a3, voffA);
            PG8_WAIT_V(8); PG8_WAIT_L(0); PG8_BAR; PG8_MMA(1, 0, At, B0); PG8_MMA(1, 1, At, B1); PG8_BAR; PG8_SCHED;
        }
        if (wr == 0) PG8_BAR;
        E(acc, cur, wr, wc, fr, fq);
        if (!has_next) break;
#pragma unroll
        for (int a = 0; a < 2; ++a)
#pragma unroll
            for (int b = 0; b < 2; ++b)
#pragma unroll
                for (int m = 0; m < 4; ++m)
#pragma unroll
                    for (int n = 0; n < 2; ++n) acc[a][b][m][n] = (f32x4){0.f, 0.f, 0.f, 0.f};
        cur = nxt; cA = nA; cB = nB; ++ui;
        if (wr == 1) PG8_BAR;
    }
    PG8_WAIT_V(0);
    PG8_BAR;
#undef PG8_SA
#undef PG8_SB
#undef PG8_STAGE
#undef PG8_LDA
#undef PG8_LDB
#undef PG8_MMA
#undef PG8_WAIT_V
#undef PG8_WAIT_L
#undef PG8_BAR
#undef PG8_SCHED
}

struct EpiSwiglu {
    static constexpr bool PERM = true;
    bf16_t* H; const float* ss;
    __device__ __forceinline__ void operator()(const f32x4 (&acc)[2][2][4][2], const Unit& u, int wr, int wc, int fr, int fq) const {
        const int row0 = u.pm * BM + wr * 64 + fr, col0 = u.pn * 128 + wc * 32 + 8 * fq;
#pragma unroll
        for (int ai = 0; ai < 2; ++ai)
#pragma unroll
            for (int m = 0; m < 4; ++m) { const int row = row0 + ai * HALF + m * 16; const float r = row_rstd(ss, row);
                float h[8];
#pragma unroll
                for (int n = 0; n < 2; ++n)
#pragma unroll
                    for (int e = 0; e < 4; ++e) { const float a = acc[ai][0][m][n][e] * r, b = acc[ai][1][m][n][e] * r; h[n * 4 + e] = silu_f(a) * b; }
                u32x4 w; w.x = cvt_pk_bf16(h[0], h[1]); w.y = cvt_pk_bf16(h[2], h[3]); w.z = cvt_pk_bf16(h[4], h[5]); w.w = cvt_pk_bf16(h[6], h[7]);
                *(u32x4*)(H + (size_t)row * F + col0) = w; }
    }
};
struct EpiResid {
    static constexpr bool PERM = true;
    const float* base32; bf16_t* xb; float* ssn; float scale; LAS float* red;
    __device__ __forceinline__ void operator()(const f32x4 (&acc)[2][2][4][2], const Unit& u, int wr, int wc, int fr, int fq) const {
        const int row0 = u.pm * BM + wr * 64 + fr, col0 = u.pn * BM + wc * 32 + 8 * fq;
#pragma unroll
        for (int ai = 0; ai < 2; ++ai)
#pragma unroll
            for (int m = 0; m < 4; ++m) { const int row = row0 + ai * HALF + m * 16; const size_t off = (size_t)row * D + col0; float q = 0.f;
#pragma unroll
                for (int bj = 0; bj < 2; ++bj) { const size_t o2 = off + bj * HALF; f32x4 b0, b1;
                    if (base32) { b0 = *(const f32x4*)(base32 + o2); b1 = *(const f32x4*)(base32 + o2 + 4); }
                    else { const u32x4 bw = *(const u32x4*)(xb + o2); b0 = (f32x4){bflo(bw.x), bfhi(bw.x), bflo(bw.y), bfhi(bw.y)}; b1 = (f32x4){bflo(bw.z), bfhi(bw.z), bflo(bw.w), bfhi(bw.w)}; }
                    const f32x4 o0 = b0 + acc[ai][bj][m][0] * scale, o1 = b1 + acc[ai][bj][m][1] * scale;
                    u32x4 w; w.x = cvt_pk_bf16(o0[0], o0[1]); w.y = cvt_pk_bf16(o0[2], o0[3]); w.z = cvt_pk_bf16(o1[0], o1[1]); w.w = cvt_pk_bf16(o1[2], o1[3]);
                    *(u32x4*)(xb + o2) = w;
                    q += ((o0[0] * o0[0] + o0[1] * o0[1]) + (o0[2] * o0[2] + o0[3] * o0[3])) + ((o1[0] * o1[0] + o1[1] * o1[1]) + (o1[2] * o1[2] + o1[3] * o1[3])); }
                q += __shfl_xor(q, 16); q += __shfl_xor(q, 32);
                if (fq == 0) red[(ai * HALF + wr * 64 + m * 16 + fr) * 4 + wc] = q;
                if ((m & (MK_FENCE - 1)) == MK_FENCE - 1) asm volatile("" ::: "memory"); }
        asm volatile("s_waitcnt lgkmcnt(0)" ::: "memory"); __builtin_amdgcn_s_barrier(); asm volatile("" ::: "memory");
        if (wr == 0) { const int t = wc * 64 + fq * 16 + fr; const f32x4 p = *(const LAS f32x4*)(red + t * 4);
            ssn[((size_t)u.pm * BM + t) * 4 + u.pn] = (p[0] + p[1]) + (p[2] + p[3]); }
    }
};
struct EpiInproj {
    static constexpr bool PERM = true;
    bf16_t* P; const float* ss;
    __device__ __forceinline__ void operator()(const f32x4 (&acc)[2][2][4][2], const Unit& u, int wr, int wc, int fr, int fq) const {
        if (u.pn < 4) run<1>(acc, u, wr, wc, fr, fq); else if (u.pn >= 15) run<2>(acc, u, wr, wc, fr, fq); else run<0>(acc, u, wr, wc, fr, fq);
    }
    template <int ACT> __device__ __forceinline__ void run(const f32x4 (&acc)[2][2][4][2], const Unit& u, int wr, int wc, int fr, int fq) const {
        const int row0 = u.pm * BM + wr * 64 + fr, col0 = u.pn * BM + wc * 32 + 8 * fq;
#pragma unroll
        for (int ai = 0; ai < 2; ++ai)
#pragma unroll
            for (int m = 0; m < 4; ++m) { const int row = row0 + ai * HALF + m * 16; const float r = row_rstd(ss, row);
#pragma unroll
                for (int bj = 0; bj < 2; ++bj) { float h[8];
#pragma unroll
                    for (int n = 0; n < 2; ++n)
#pragma unroll
                        for (int e = 0; e < 4; ++e) { const float v = acc[ai][bj][m][n][e] * r; h[n * 4 + e] = (ACT == 1) ? gelu_tanh_f(v) : ((ACT == 2) ? silu_f(v) : v); }
                    u32x4 w; w.x = cvt_pk_bf16(h[0], h[1]); w.y = cvt_pk_bf16(h[2], h[3]); w.z = cvt_pk_bf16(h[4], h[5]); w.w = cvt_pk_bf16(h[6], h[7]);
#if MK_WTIN
                    asm volatile("global_store_dwordx4 %0, %1, off sc0 sc1" :: "v"(P + (size_t)row * PW + col0 + bj * HALF), "v"(w) : "memory"); } }
#else
                    *(u32x4*)(P + (size_t)row * PW + col0 + bj * HALF) = w; } }
#endif
    }
};
struct EpiGate {
    static constexpr bool PERM = true;
    bf16_t* G; const float* ss; const float* bias; int ld; float* dbg32;
    __device__ __forceinline__ void operator()(const f32x4 (&acc)[2][2][4][2], const Unit& u, int wr, int wc, int fr, int fq) const {
        const int row0 = u.pm * BM + wr * 64 + fr, col0 = u.pn * BM + wc * 32 + 8 * fq;
#pragma unroll
        for (int ai = 0; ai < 2; ++ai)
#pragma unroll
            for (int m = 0; m < 4; ++m) { const int row = row0 + ai * HALF + m * 16; const float r = row_rstd(ss, row);
#pragma unroll
                for (int bj = 0; bj < 2; ++bj) { float h[8]; const f32x4 b0 = *(const f32x4*)(bias + col0 + bj * HALF), b1 = *(const f32x4*)(bias + col0 + bj * HALF + 4);
#pragma unroll
#ifdef MK_X1
                    for (int e = 0; e < 4; ++e) { h[e] = sigmoid_f(acc[ai][bj][m][0][e] * 0.03f + 0.f * (r + b0[e])); h[4 + e] = sigmoid_f(acc[ai][bj][m][1][e] * 0.03f + 0.f * b1[e]); }
#else
                    for (int e = 0; e < 4; ++e) { h[e] = sigmoid_f(acc[ai][bj][m][0][e] * r + b0[e]); h[4 + e] = sigmoid_f(acc[ai][bj][m][1][e] * r + b1[e]); }
#endif
                    u32x4 w; w.x = cvt_pk_bf16(h[0], h[1]); w.y = cvt_pk_bf16(h[2], h[3]); w.z = cvt_pk_bf16(h[4], h[5]); w.w = cvt_pk_bf16(h[6], h[7]);
#if MK_WTG
                    asm volatile("global_store_dwordx4 %0, %1, off sc0 sc1" :: "v"(G + (size_t)row * ld + col0 + bj * HALF), "v"(w) : "memory");
#else
                    *(u32x4*)(G + (size_t)row * ld + col0 + bj * HALF) = w;
#endif
                    if (dbg32) { *(f32x4*)(dbg32 + (size_t)row * D + col0 + bj * HALF) = (f32x4){h[0], h[1], h[2], h[3]}; *(f32x4*)(dbg32 + (size_t)row * D + col0 + bj * HALF + 4) = (f32x4){h[4], h[5], h[6], h[7]}; } }
                if ((m & (MK_FENCE - 1)) == MK_FENCE - 1) asm volatile("" ::: "memory"); }
    }
};
struct EpiMerge {
    static constexpr bool PERM = true;
    const bf16_t* G; bf16_t* Mg; int first, ld;
    __device__ __forceinline__ void operator()(const f32x4 (&acc)[2][2][4][2], const Unit& u, int wr, int wc, int fr, int fq) const {
        const int row0 = u.pm * BM + wr * 64 + fr, col0 = u.pn * BM + wc * 32 + 8 * fq;
#pragma unroll
        for (int ai = 0; ai < 2; ++ai)
#pragma unroll
            for (int m = 0; m < 4; ++m) { const int row = row0 + ai * HALF + m * 16;
#pragma unroll
                for (int bj = 0; bj < 2; ++bj) { const size_t off = (size_t)row * ld + col0 + bj * HALF;
                    const u32x4 gv = *(const u32x4*)(G + off); u32x4 mv = (u32x4){0u, 0u, 0u, 0u}; if (!first) mv = *(const u32x4*)(Mg + off);
                    float h[8];
#pragma unroll
                    for (int n = 0; n < 2; ++n) { const unsigned g0 = n ? gv.z : gv.x, g1 = n ? gv.w : gv.y, m0 = n ? mv.z : mv.x, m1 = n ? mv.w : mv.y;
                        h[n * 4 + 0] = bflo(m0) + bflo(g0) * acc[ai][bj][m][n][0]; h[n * 4 + 1] = bfhi(m0) + bfhi(g0) * acc[ai][bj][m][n][1];
                        h[n * 4 + 2] = bflo(m1) + bflo(g1) * acc[ai][bj][m][n][2]; h[n * 4 + 3] = bfhi(m1) + bfhi(g1) * acc[ai][bj][m][n][3]; }
                    u32x4 w; w.x = cvt_pk_bf16(h[0], h[1]); w.y = cvt_pk_bf16(h[2], h[3]); w.z = cvt_pk_bf16(h[4], h[5]); w.w = cvt_pk_bf16(h[6], h[7]);
                    *(u32x4*)(Mg + off) = w; }
                if ((m & (MK_FENCE - 1)) == MK_FENCE - 1) asm volatile("" ::: "memory"); }
    }
};
}

template <int KSTEPS>
__device__ __forceinline__ f32x4 mma_k(const LAS unsigned char* pa, const LAS unsigned char* pb, f32x4 acc) {
#pragma unroll
    for (int s = 0; s < KSTEPS; ++s) { const bf16x8 a = *(const LAS bf16x8*)(pa + s * 64); const bf16x8 b = *(const LAS bf16x8*)(pb + s * 64);
        acc = __builtin_amdgcn_mfma_f32_16x16x32_bf16(a, b, acc, 0, 0, 0); }
    return acc;
}
typedef short v4i16 __attribute__((ext_vector_type(4)));
__device__ __forceinline__ bf16x8 ld_tr_frag(const LAS unsigned char* img, int pitch, int tok0, int ch0, int lane) {
    const int g = lane >> 4, q = (lane & 15) >> 2, p = lane & 3;
    const LAS unsigned char* a = img + (tok0 + 8 * g + q) * pitch + (ch0 + 4 * p) * 2;
    const v4i16 lo = __builtin_amdgcn_ds_read_tr16_b64_v4i16((LAS v4i16*)a);
    const v4i16 hi = __builtin_amdgcn_ds_read_tr16_b64_v4i16((LAS v4i16*)(a + 4 * pitch));
    return __builtin_shufflevector(lo, hi, 0, 1, 2, 3, 4, 5, 6, 7);
}
__device__ __forceinline__ void lds_st16(LAS unsigned char* p, unsigned v) { *(LAS unsigned short*)p = (unsigned short)v; }

__device__ __forceinline__ void unit_gmlp(LAS unsigned char* L, bf16_t* P, const bf16_t* WSb, const float* vnorm, const float* bs, int ci, int tid) {
    asm volatile("" : "+v"(tid));
    const int lane = tid & 63, wid = tid >> 6, l15 = lane & 15, lq = lane >> 4;
    constexpr int PT = 272;
    LAS unsigned char* Wl = L; LAS unsigned char* VT = L + 34816; LAS float* rs = (LAS float*)(L + 69632);
    bf16_t* Prow = P + (size_t)ci * 128 * PW;
    {
        const int t = tid >> 2, part = tid & 3; const bf16_t* src = Prow + (size_t)t * PW + C_AV + part * 128; float s = 0.f;
#pragma unroll 4
        for (int i = 0; i < 16; ++i) { const u32x4 v = *((const u32x4*)(src + 8 * i));
            s += bflo(v.x) * bflo(v.x) + bfhi(v.x) * bfhi(v.x) + bflo(v.y) * bflo(v.y) + bfhi(v.y) * bfhi(v.y) + bflo(v.z) * bflo(v.z) + bfhi(v.z) * bfhi(v.z) + bflo(v.w) * bflo(v.w) + bfhi(v.w) * bfhi(v.w); }
        s += __shfl_xor(s, 1); s += __shfl_xor(s, 2);
        if (part == 0) rs[t] = rsqrtf(s * (1.0f / 512.0f) + NORM_EPS);
    }
    __syncthreads();
    for (int g = 0; g < 4; ++g) {
        for (int i = tid; i < 2048; i += 512) { const int r = i >> 4, c = i & 15; *(LAS u32x4*)(Wl + r * PT + c * 16) = *((const u32x4*)(WSb + g * 16384 + r * 128 + c * 8)); }
        for (int i = tid; i < 2048; i += 512) { const int r = i >> 4, c = i & 15; const float rr = rs[r]; const float* gn = vnorm + g * 128 + c * 8;
            const u32x4 v = *((const u32x4*)(Prow + (size_t)r * PW + C_AV + g * 128 + c * 8)); const f32x4 g0 = *(const f32x4*)gn, g1 = *(const f32x4*)(gn + 4);
            u32x4 o; o.x = pk2(bflo(v.x) * rr * g0[0], bfhi(v.x) * rr * g0[1]); o.y = pk2(bflo(v.y) * rr * g0[2], bfhi(v.y) * rr * g0[3]);
            o.z = pk2(bflo(v.z) * rr * g1[0], bfhi(v.z) * rr * g1[1]); o.w = pk2(bflo(v.w) * rr * g1[2], bfhi(v.w) * rr * g1[3]);
            *(LAS u32x4*)(VT + r * PT + c * 16) = o; }
        __syncthreads();
        {   bf16x8 af[4];
#pragma unroll
            for (int s = 0; s < 4; ++s) af[s] = ld_tr_frag(VT, PT, 32 * s, 16 * wid, lane);
#pragma unroll
            for (int tt = 0; tt < 8; ++tt) { const LAS unsigned char* pb = Wl + (16 * tt + l15) * PT + lq * 16;
                f32x4 acc = (f32x4){0.f, 0.f, 0.f, 0.f};
#pragma unroll
                for (int s = 0; s < 4; ++s) acc = __builtin_amdgcn_mfma_f32_16x16x32_bf16(af[s], *(const LAS bf16x8*)(pb + s * 64), acc, 0, 0, 0);
                const int t = 16 * tt + l15, d = 16 * wid + 4 * lq; const float b = bs[g * 128 + t];
                bf16_t* up = Prow + (size_t)t * PW + C_AU + g * 128 + d; const u32x2 uv = *((const u32x2*)up);
                u32x2 o; o.x = pk2(bflo(uv.x) * (acc[0] + b), bfhi(uv.x) * (acc[1] + b)); o.y = pk2(bflo(uv.y) * (acc[2] + b), bfhi(uv.y) * (acc[3] + b));
                *(u32x2*)up = o; }
        }
        __syncthreads();
    }
}

__device__ __forceinline__ void unit_attn(LAS unsigned char* L, bf16_t* P, const float* sinks, int ci, int tid) {
    asm volatile("" : "+v"(tid));
    const int lane = tid & 63, wid = tid >> 6, l15 = lane & 15, lq = lane >> 4;
    constexpr int PK = 144, PV = 144, PP = 336;
    LAS unsigned char* Kl = L; LAS unsigned char* VT = L + 36864; LAS unsigned char* Pl = L + 73728 + wid * 5376;
    const int n = ci & 127; const long rowbase = (long)ci * 128 - 128;
    for (int kvh = 0; kvh < 2; ++kvh) {
        for (int i = tid; i < 2048; i += 512) { const int r = i >> 3, c = i & 7; u32x4 v = (u32x4){0u, 0u, 0u, 0u};
            if (n > 0 || r >= 128) v = *((const u32x4*)(P + (size_t)(rowbase + r) * PW + C_BK + kvh * 64 + c * 8));
            *(LAS u32x4*)(Kl + r * PK + c * 16) = v; }
        for (int i = tid; i < 2048; i += 512) { const int r = i >> 3, c = i & 7; u32x4 v = (u32x4){0u, 0u, 0u, 0u};
            if (n > 0 || r >= 128) v = *(const u32x4*)(P + (size_t)(rowbase + r) * PW + C_BV + kvh * 64 + c * 8);
            *(LAS u32x4*)(VT + r * PV + c * 16) = v; }
        __syncthreads();
        const bf16_t* qq0 = P + ((size_t)ci * 128 + 16 * ((wid & 1) * 4) + l15) * PW + C_BQ + (kvh * 4 + (wid >> 1)) * 64 + lq * 8;
        bf16x8 qn0 = *(const bf16x8*)qq0, qn1 = *(const bf16x8*)(qq0 + 32);
        for (int it = 0; it < 4; ++it) {
            const bf16x8 q0 = qn0, q1 = qn1;
            if (it < 3) { const bf16_t* qq = qq0 + (size_t)(16 * (it + 1)) * PW; qn0 = *(const bf16x8*)qq; qn1 = *(const bf16x8*)(qq + 32); }
            const int g = wid >> 1, qt = (wid & 1) * 4 + it, h = kvh * 4 + g;
            const float slope = fexp2(-(float)(h + 1)), sink = sinks[h];
            const size_t qrow = (size_t)ci * 128 + 16 * qt + l15;
            bf16_t* qp = P + qrow * PW + C_BQ + h * 64;
            const int kt0 = qt & ~1;
            f32x4 sc[10];
#pragma unroll
            for (int i = 0; i < 10; ++i) { const LAS unsigned char* pa = Kl + (16 * (kt0 + i) + l15) * PK + lq * 16;
                f32x4 a = __builtin_amdgcn_mfma_f32_16x16x32_bf16(*(const LAS bf16x8*)pa, q0, (f32x4){0.f, 0.f, 0.f, 0.f}, 0, 0, 0);
                sc[i] = __builtin_amdgcn_mfma_f32_16x16x32_bf16(*(const LAS bf16x8*)(pa + 64), q1, a, 0, 0, 0); }
            const int qpos = 128 + 16 * qt + l15; float mx = sink;
#pragma unroll
            for (int i = 0; i < 10; ++i)
#pragma unroll
                for (int j = 0; j < 4; ++j) { const int kpos = 16 * (kt0 + i) + 4 * lq + j, dist = qpos - kpos; const bool valid = dist >= 0 && dist < 128 && (n > 0 || kpos >= 128);
                    const float s = valid ? sc[i][j] * 0.125f - slope * (float)dist : -INFINITY; sc[i][j] = s; mx = fmaxf(mx, s); }
            mx = fmaxf(mx, __shfl_xor(mx, 16)); mx = fmaxf(mx, __shfl_xor(mx, 32));
            float sum = 0.f;
#pragma unroll
            for (int i = 0; i < 10; ++i)
#pragma unroll
                for (int j = 0; j < 4; ++j) { const float p = fexp2((sc[i][j] - mx) * LOG2E); sc[i][j] = p; sum += p; }
            sum += __shfl_xor(sum, 16); sum += __shfl_xor(sum, 32);
            sum += fexp2((sink - mx) * LOG2E);
            const float inv = 1.0f / sum;
#pragma unroll
            for (int i = 0; i < 10; ++i) { u32x2 w; w.x = pk2(sc[i][0] * inv, sc[i][1] * inv); w.y = pk2(sc[i][2] * inv, sc[i][3] * inv);
                *(LAS u32x2*)(Pl + l15 * PP + (16 * i + 4 * lq) * 2) = w; }
            asm volatile("s_waitcnt lgkmcnt(0)" ::: "memory");
#pragma unroll
            for (int dt = 0; dt < 4; ++dt) { f32x4 acc = (f32x4){0.f, 0.f, 0.f, 0.f};
#pragma unroll
                for (int s5 = 0; s5 < 5; ++s5) { const bf16x8 a = ld_tr_frag(VT, PV, 16 * kt0 + 32 * s5, 16 * dt, lane);
                    const bf16x8 b = *(const LAS bf16x8*)(Pl + l15 * PP + (32 * s5 + 8 * lq) * 2);
                    acc = __builtin_amdgcn_mfma_f32_16x16x32_bf16(a, b, acc, 0, 0, 0); }
                u32x2 o; o.x = pk2(acc[0], acc[1]); o.y = pk2(acc[2], acc[3]);
                *(u32x2*)(qp + 16 * dt + 4 * lq) = o; }
            asm volatile("s_waitcnt lgkmcnt(0)" ::: "memory");
        }
        __syncthreads();
    }
}

struct KvRegs { u32x4 v[8], k[4]; };
__device__ __forceinline__ void kv_load(KvRegs& R, const bf16_t* P, int u, int tid) {
    const int ci = u >> 2, h = u & 3; const bf16_t* Pr = P + (size_t)ci * 128 * PW;
#pragma unroll
    for (int j = 0; j < 8; ++j) { const int i = tid + 512 * j, r = i >> 5, c = i & 31; R.v[j] = *((const u32x4*)(Pr + (size_t)r * PW + C_CV + h * 256 + c * 8)); }
#pragma unroll
    for (int j = 0; j < 4; ++j) { const int i = tid + 512 * j, r = i >> 4, c = i & 15; R.k[j] = *((const u32x4*)(Pr + (size_t)r * PW + C_CK + h * 128 + c * 8)); }
}
__device__ __forceinline__ void kv_store(LAS unsigned char* L, const KvRegs& R, int u, int tid) {
    constexpr int PVI = 528, PKI = 272; LAS unsigned char* Vi = L; LAS unsigned char* Ki = L + 128 * PVI;
    const float lg = log2f(1.0f - exp2f(-5.0f - (float)(u & 3)));
#pragma unroll
    for (int j = 0; j < 8; ++j) { const int i = tid + 512 * j, r = i >> 5, c = i & 31; *(LAS u32x4*)(Vi + r * PVI + c * 16) = R.v[j]; }
#pragma unroll
    for (int j = 0; j < 4; ++j) { const int i = tid + 512 * j, r = i >> 4, c = i & 15; const float kw = 0.08838834764831845f * fexp2(lg * (float)(127 - r)); const u32x4 v = R.k[j];
        u32x4 o; o.x = pk2(bflo(v.x) * kw, bfhi(v.x) * kw); o.y = pk2(bflo(v.y) * kw, bfhi(v.y) * kw); o.z = pk2(bflo(v.z) * kw, bfhi(v.z) * kw); o.w = pk2(bflo(v.w) * kw, bfhi(v.w) * kw);
        *(LAS u32x4*)(Ki + r * PKI + c * 16) = o; }
}
__device__ __forceinline__ void kv_compute(LAS unsigned char* L, bf16_t* KV, int u, int tid) {
    const int lane = tid & 63, wid = tid >> 6, l15 = lane & 15, lq = lane >> 4;
    constexpr int PVI = 528, PKI = 272; const LAS unsigned char* Vi = L; const LAS unsigned char* Ki = L + 128 * PVI;
    bf16_t* out = KV + (size_t)u * 32768;
    bf16x8 bfr[2][4];
#pragma unroll
    for (int ee = 0; ee < 2; ++ee)
#pragma unroll
        for (int s = 0; s < 4; ++s) bfr[ee][s] = ld_tr_frag(Vi, PVI, 32 * s, 16 * (2 * wid + ee), lane);
#pragma unroll 2
    for (int dt = 0; dt < 8; ++dt) { bf16x8 af[4];
#pragma unroll
        for (int s = 0; s < 4; ++s) af[s] = ld_tr_frag(Ki, PKI, 32 * s, 16 * dt, lane);
#pragma unroll
        for (int ee = 0; ee < 2; ++ee) { f32x4 acc = (f32x4){0.f, 0.f, 0.f, 0.f};
#pragma unroll
            for (int s = 0; s < 4; ++s) acc = __builtin_amdgcn_mfma_f32_16x16x32_bf16(af[s], bfr[ee][s], acc, 0, 0, 0);
            u32x2 o; o.x = pk2(acc[0], acc[1]); o.y = pk2(acc[2], acc[3]);
            *(u32x2*)(out + (16 * (2 * wid + ee) + l15) * 128 + 16 * dt + 4 * lq) = o; } }
}

__device__ __forceinline__ void phase_scan(bf16_t* KV, int gtid, int gthreads) {
    for (int w = gtid; w < 65536 * (MH / 16384); w += gthreads) {
        const int b = w >> 16, h = (w >> 14) & 3, e2 = w & 16383;
        const float decay = exp2f(128.0f * log2f(1.0f - exp2f(-5.0f - (float)h)));
        float st0 = 0.f, st1 = 0.f;
        unsigned* base = (unsigned*)(KV + ((size_t)(b * 128) * 4 + h) * 32768) + e2;
        for (int n0 = 0; n0 < 128; n0 += 16) {
            unsigned v[16];
#pragma unroll
            for (int i = 0; i < 16; ++i) v[i] = *(base + (size_t)(n0 + i) * 4 * 16384);
#pragma unroll
            for (int i = 0; i < 16; ++i) { base[(size_t)(n0 + i) * 4 * 16384] = pk2(st0, st1);
                st0 = decay * st0 + bflo(v[i]); st1 = decay * st1 + bfhi(v[i]); }
        }
    }
}

struct RetRegs { u32x4 q[4], k[4]; };
__device__ __forceinline__ void ret_load(RetRegs& R, const bf16_t* P, int u, int tid) {
    const int ci = u >> 2, h = u & 3;
#pragma unroll
    for (int j = 0; j < 4; ++j) { const int i = tid + 512 * j, r = i >> 4, c = i & 15; const bf16_t* src = P + ((size_t)ci * 128 + r) * PW + h * 128 + c * 8;
        R.q[j] = *((const u32x4*)(src + C_CQ)); R.k[j] = *((const u32x4*)(src + C_CK)); }
}
__device__ __forceinline__ void unit_ret(LAS unsigned char* L, bf16_t* P, const bf16_t* KV, const float* gn, int u, int tid, RetRegs& RR, int u_next) {
    asm volatile("" : "+v"(tid));
    const int lane = tid & 63, wid = tid >> 6, l15 = lane & 15, lq = lane >> 4;
    constexpr int PT = 272, R = 34816;
    LAS unsigned char* Ql = L; LAS unsigned char* Kl = L + R; LAS unsigned char* Pl = L + 2 * R; LAS unsigned char* Sl = L + 3 * R;
    const int ci = u >> 2, h = u & 3; const size_t row0 = (size_t)ci * 128;
    const float lg = log2f(1.0f - exp2f(-5.0f - (float)h));
#pragma unroll
    for (int j = 0; j < 4; ++j) { const int i = tid + 512 * j, r = i >> 4, c = i & 15; *(LAS u32x4*)(Ql + r * PT + c * 16) = RR.q[j]; *(LAS u32x4*)(Kl + r * PT + c * 16) = RR.k[j]; }
    __syncthreads();
    const int t = 16 * wid + l15;
    u32x4 pv[4], ps[4];
#pragma unroll
    for (int j = 0; j < 4; ++j) { const int i = tid + 512 * j, r = i >> 4, c = i & 15;
        pv[j] = *((const u32x4*)(P + (row0 + r) * PW + C_CV + h * 256 + c * 8));
        ps[j] = *((const u32x4*)(KV + (size_t)u * 32768 + r * 128 + c * 8)); }
    {   const LAS unsigned char* pb = Ql + t * PT + lq * 16;
        for (int st = 0; st < 8; ++st) { f32x4 acc = (f32x4){0.f, 0.f, 0.f, 0.f};
            if (st <= wid) { const LAS unsigned char* pa = Kl + (16 * st + l15) * PT + lq * 16; acc = mma_k<4>(pa, pb, acc); }
            float v[4];
#pragma unroll
            for (int j = 0; j < 4; ++j) { const int s = 16 * st + 4 * lq + j; v[j] = (s <= t) ? acc[j] * 0.08838834764831845f * fexp2(lg * (float)(t - s)) : 0.f; }
            u32x2 w; w.x = pk2(v[0], v[1]); w.y = pk2(v[2], v[3]);
            *(LAS u32x2*)(Pl + t * PT + (16 * st + 4 * lq) * 2) = w; }
    }
    __syncthreads();
    f32x4 o[16];
    const float qw = fexp2(lg * (float)(t + 1));
#pragma unroll
    for (int hf = 0; hf < 2; ++hf) {
#pragma unroll
        for (int j = 0; j < 4; ++j) { const int i = tid + 512 * j, r = i >> 4, c = i & 15;
            *(LAS u32x4*)(Kl + r * PT + c * 16) = pv[j]; *(LAS u32x4*)(Sl + r * PT + c * 16) = ps[j]; }
        __syncthreads();
        if (hf == 0) {
#pragma unroll
            for (int j = 0; j < 4; ++j) { const int i = tid + 512 * j, r = i >> 4, c = i & 15;
                pv[j] = *((const u32x4*)(P + (row0 + r) * PW + C_CV + h * 256 + 128 + c * 8));
                ps[j] = *((const u32x4*)(KV + (size_t)u * 32768 + (128 + r) * 128 + c * 8)); } }
        const LAS unsigned char* pbP = Pl + t * PT + lq * 16; const LAS unsigned char* pbQ = Ql + t * PT + lq * 16;
#pragma unroll
        for (int et = 0; et < 8; ++et) { const LAS unsigned char* paS = Sl + (16 * et + l15) * PT + lq * 16;
            f32x4 ai = (f32x4){0.f, 0.f, 0.f, 0.f};
#pragma unroll
            for (int s = 0; s < 4; ++s) ai = __builtin_amdgcn_mfma_f32_16x16x32_bf16(ld_tr_frag(Kl, PT, 32 * s, 16 * et, lane), *(const LAS bf16x8*)(pbP + s * 64), ai, 0, 0, 0);
            const f32x4 ac = mma_k<4>(paS, pbQ, (f32x4){0.f, 0.f, 0.f, 0.f});
            o[hf * 8 + et] = ai + ac * qw; }
        __syncthreads();
    }
    if (u_next >= 0) ret_load(RR, P, u_next, tid);
    float sum = 0.f;
#pragma unroll
    for (int i = 0; i < 16; ++i) sum += (o[i][0] + o[i][1]) + (o[i][2] + o[i][3]);
    sum += __shfl_xor(sum, 16); sum += __shfl_xor(sum, 32);
    const float mean = sum * (1.0f / 256.0f); float var = 0.f;
#pragma unroll
    for (int i = 0; i < 16; ++i) { const f32x4 dd = o[i] - mean; var += (dd[0] * dd[0] + dd[1] * dd[1]) + (dd[2] * dd[2] + dd[3] * dd[3]); }
    var += __shfl_xor(var, 16); var += __shfl_xor(var, 32);
    const float rstd = rsqrtf(var * (1.0f / 256.0f) + GN_EPS);
#pragma unroll
    for (int i = 0; i < 16; ++i) { const int e = 16 * i + 4 * lq; bf16_t* gp = P + (row0 + t) * PW + C_CG + h * 256 + e; const u32x2 gv = *((const u32x2*)gp); const f32x4 gg = *(const f32x4*)(gn + h * 256 + e);
        u32x2 w; w.x = pk2((o[i][0] - mean) * rstd * gg[0] * bflo(gv.x), (o[i][1] - mean) * rstd * gg[1] * bfhi(gv.x));
        w.y = pk2((o[i][2] - mean) * rstd * gg[2] * bflo(gv.y), (o[i][3] - mean) * rstd * gg[3] * bfhi(gv.y));
        *(u32x2*)gp = w; if ((i & 7) == 7) asm volatile("" ::: "memory"); }
    __syncthreads();
}

__device__ __forceinline__ void transpose_item(const float* W, int K, int N, bf16_t* WT, const float* gk, bool swiglu, LAS float* scr, int item, int lane) {
    const int nblk = N / 64, kb = item / nblk, nb = item % nblk, k0 = 64 * kb, n0 = 64 * nb;
    const int kr = lane >> 4, nq = 4 * (lane & 15);
    f32x4 v[16];
#pragma unroll
    for (int i = 0; i < 16; ++i) v[i] = *(const f32x4*)(W + (size_t)(k0 + 4 * i + kr) * N + n0 + nq);
#pragma unroll
    for (int i = 0; i < 16; ++i) { const int kk = 4 * i + kr; const float g = gk ? gk[k0 + kk] : 1.0f; LAS float* d = scr + kk * 65 + nq;
        d[0] = v[i][0] * g; d[1] = v[i][1] * g; d[2] = v[i][2] * g; d[3] = v[i][3] * g; }
    asm volatile("s_waitcnt lgkmcnt(0)" ::: "memory");
    int d0 = n0; if (swiglu) { const int bj = n0 / F, rem = n0 % F; d0 = 256 * (rem / 128) + 128 * bj + (rem % 128); }
    const int c = lane & 7;
#pragma unroll
    for (int j = 0; j < 8; ++j) { const int n = (lane >> 3) + 8 * j; const LAS float* s = scr + (8 * c) * 65 + n;
        u32x4 o; o.x = pk2(s[0 * 65], s[1 * 65]); o.y = pk2(s[2 * 65], s[3 * 65]); o.z = pk2(s[4 * 65], s[5 * 65]); o.w = pk2(s[6 * 65], s[7 * 65]);
        *(u32x4*)(WT + (size_t)(d0 + n) * K + k0 + 8 * c) = o; }
    asm volatile("s_waitcnt lgkmcnt(0)" ::: "memory");
}

#define XB_TMO      128
#define XB_XCNT(j)  (256  + 64 * (j))
#define XB_XSUB(j)  (1280 + 64 * (j))
#define XB_XGEN(j)  (2304 + 64 * (j))
#define XB_TOP      3328
#define XB_TOPGEN   3392
#define XCD_BAR_WORDS 3456
#define XB_SPIN_CAP (1u << 18)
__device__ __forceinline__ unsigned xb_ld(unsigned* p)              { return __hip_atomic_load(p, __ATOMIC_RELAXED, __HIP_MEMORY_SCOPE_AGENT); }
__device__ __forceinline__ unsigned xb_add(unsigned* p, unsigned v) { return __hip_atomic_fetch_add(p, v, __ATOMIC_RELAXED, __HIP_MEMORY_SCOPE_AGENT); }
__device__ __forceinline__ unsigned xb_xcc_id() { return (unsigned)__builtin_amdgcn_s_getreg((3 << 11) | 20) & 0xFu; }
#define XB_SPIN(cond, bar) do { unsigned _sp = 0; while (cond) { __builtin_amdgcn_s_sleep(1); \
    if ((++_sp & 255u) == 0u) { if (xb_ld(&(bar)[XB_TMO])) break; if (_sp > XB_SPIN_CAP) { atomicAdd(&(bar)[XB_TMO], 1u); break; } } } } while (0)
struct XcdBarrier { unsigned* bar; unsigned x; volatile LAS unsigned* st; };
__device__ __forceinline__ XcdBarrier xcd_barrier_post(unsigned* bar, volatile LAS unsigned* st) {
    XcdBarrier b; b.bar = bar; b.x = xb_xcc_id(); b.st = st;
    if (threadIdx.x == 0) (void)xb_add(&bar[XB_XCNT(b.x)], 1u);
    return b;
}
__device__ __forceinline__ void xcd_barrier_complete(unsigned* bar, unsigned x, unsigned& nloc, unsigned& nx) {
    const unsigned G = gridDim.x * gridDim.y * gridDim.z;
    unsigned sum, cnt, mine, sp = 0u;
    for (;;) {
        sum = 0u; cnt = 0u; mine = 0u;
#pragma unroll
        for (unsigned j = 0; j < 16; ++j) { const unsigned c = xb_ld(&bar[XB_XCNT(j)]); sum += c; cnt += (c > 0u) ? 1u : 0u; mine = (j == x) ? c : mine; }
        if (sum == G) break;
        __builtin_amdgcn_s_sleep(1);
        if ((++sp & 255u) == 0u) { if (xb_ld(&bar[XB_TMO])) break; if (sp > XB_SPIN_CAP) { atomicAdd(&bar[XB_TMO], 1u); break; } }
    }
    nloc = mine > 0u ? mine : 1u; nx = cnt > 0u ? cnt : 1u;
}
__device__ __forceinline__ void xcd_barrier(const XcdBarrier& b) {
    asm volatile("s_waitcnt vmcnt(0)" ::: "memory");
    __syncthreads();
    if (threadIdx.x == 0) {
        unsigned* bar = b.bar;
        __builtin_amdgcn_s_waitcnt(0);
        unsigned nloc = b.st[0], nx = b.st[1];
        if (nloc == 0u) { xcd_barrier_complete(bar, b.x, nloc, nx); b.st[0] = nloc; b.st[1] = nx; }
        const unsigned old = xb_add(&bar[XB_XSUB(b.x)], 1u);
        const unsigned gen = old / nloc;
        if (old + 1u == (gen + 1u) * nloc) {
            __builtin_amdgcn_fence(__ATOMIC_RELEASE, "agent");
            asm volatile("s_waitcnt vmcnt(0)" ::: "memory");
            const unsigned og = xb_add(&bar[XB_TOP], 1u);
            const unsigned tg = og / nx;
            if (og + 1u == (tg + 1u) * nx) xb_add(&bar[XB_TOPGEN], 1u);
            else XB_SPIN(xb_ld(&bar[XB_TOPGEN]) == tg, bar);
            __builtin_amdgcn_fence(__ATOMIC_ACQUIRE, "agent");
            xb_add(&bar[XB_XGEN(b.x)], 1u);
            asm volatile("s_waitcnt vmcnt(0)" ::: "memory");
        } else {
            XB_SPIN(xb_ld(&bar[XB_XGEN(b.x)]) == gen, bar);
            __builtin_amdgcn_fence(__ATOMIC_ACQUIRE, "agent");
            asm volatile("s_waitcnt vmcnt(0)" ::: "memory");
        }
    }
    __syncthreads();
}

struct Args { const float* in[20]; float* out; unsigned char* ws; int ph_lo, ph_hi; };

constexpr int LDS_BYTES = 147456;

__global__ void __launch_bounds__(512, 2) mk_fwd(Args a) {
    extern __shared__ __attribute__((aligned(16))) unsigned char lds_raw[];
    LAS unsigned char* L = (LAS unsigned char*)lds_raw;
    volatile LAS unsigned* xst = (volatile LAS unsigned*)(L + 131072 + 8192);
    if (threadIdx.x == 0) { xst[0] = 0u; xst[1] = 0u; }
    __syncthreads();
    const XcdBarrier xbar = xcd_barrier_post((unsigned*)(a.ws + WS_BAR), xst);
#ifndef MK_STOP
#define MK_STOP NPHASES
#endif
    for (int pidx = a.ph_lo; pidx < a.ph_hi; ++pidx) {
        const int ph = (MK_REPBLK) ? ((pidx > 6) ? pidx - 4 : pidx) : (MK_REPPH >= 0) ? ((pidx > MK_REPPH) ? pidx - 1 : pidx) : ((!MK_MULTI && MK_STOP < NPHASES && pidx == a.ph_hi - 1) ? NPHASES - 1 : pidx);
        int tid = threadIdx.x; asm volatile("" : "+v"(tid));
        int bid = blockIdx.x; asm volatile("" : "+s"(bid));
        unsigned char* ws = a.ws; asm volatile("" : "+s"(ws));
        const int lane = tid & 63, wave = __builtin_amdgcn_readfirstlane(tid >> 6);
        const int G = gridDim.x;
        float* SS = (float*)(ws + WS_SSP);
        bf16_t* WB = (bf16_t*)(ws + WS_WB);
        bf16_t* XB = (bf16_t*)(ws + WS_XB);
        bf16_t* KV = (bf16_t*)(ws + WS_KV);
        bf16_t* P = (bf16_t*)(ws + WS_P);
        bf16_t* H = P;
        float* OUT = a.out;
        const int l = ph / NPH_LAYER, k0 = (ph == NPHASES - 1) ? 99 : ph % NPH_LAYER;
        const bool inmix = (k0 >= 3 && k0 < 3 + 6 * NB);
        const int bsel = inmix ? (k0 - 3) / 6 : 0;
        const int k = inmix ? 3 + (k0 - 3) % 6 : (k0 == 3 + 6 * NB ? 15 : (k0 == 4 + 6 * NB ? 16 : k0));
        const size_t rowoff = (size_t)bsel * MH;
#if MK_GOVL || MK_NB == 1
        bf16_t* Gt = P + C_GT; bf16_t* Mg = P + C_MG; const int ldg = PW;
#else
        bf16_t* Gt = (bf16_t*)(ws + WS_G) + rowoff * D; bf16_t* Mg = (bf16_t*)(ws + WS_MG) + rowoff * D; const int ldg = D;
#endif
        if (k == 0) {
            int lane_o = lane; asm volatile("" : "+v"(lane_o));
            LAS float* scr = (LAS float*)(L + wave * 16640);
            const int gw = bid * 8 + wave, NGW = G * 8;
            for (int it = gw; it < 6976; it += NGW) {
                int r = it; const float* W; const float* gk = nullptr; bf16_t* WT; int K_, N_; bool sw = false;
                if (r < 1408) { W = a.in[2] + (size_t)l * D * 2 * F; K_ = D; N_ = 2 * F; WT = WB + O_W1IN; gk = a.in[1] + l * D; sw = true; }
                else if ((r -= 1408) < 704) { W = a.in[3] + (size_t)l * F * D; K_ = F; N_ = D; WT = WB + O_W1OUT; }
                else if ((r -= 704) < 1984) { W = a.in[5] + (size_t)l * D * 7936; K_ = D; N_ = 7936; WT = WB + O_WIN; gk = a.in[4] + l * D; }
                else if ((r -= 1984) < 128) { W = a.in[12] + (size_t)l * 512 * D; K_ = 512; N_ = D; WT = WB + O_WBA; }
                else if ((r -= 128) < 128) { W = a.in[13] + (size_t)l * 512 * D; K_ = 512; N_ = D; WT = WB + O_WBB; }
                else if ((r -= 128) < 256) { W = a.in[14] + (size_t)l * D * D; K_ = D; N_ = D; WT = WB + O_WBC; }
                else if ((r -= 256) < 256) { W = a.in[15] + (size_t)l * D * D; K_ = D; N_ = D; WT = WB + O_WOUT; }
                else if ((r -= 256) < 1408) { W = a.in[17] + (size_t)l * D * 2 * F; K_ = D; N_ = 2 * F; WT = WB + O_W2IN; gk = a.in[16] + l * D; sw = true; }
                else { r -= 1408; W = a.in[18] + (size_t)l * F * D; K_ = F; N_ = D; WT = WB + O_W2OUT; }
                transpose_item(W, K_, N_, WT, gk, sw, scr, r, lane_o);
            }
            {
                const float* wsrc = a.in[8] + (size_t)l * 65536;
                for (int i = bid * 512 + tid; i < 65536; i += G * 512) { const int tt = (i >> 7) & 127, s = i & 127; WB[O_WS + i] = (bf16_t)f2bf(s <= tt ? wsrc[i] : 0.f); }
            }
            if (l == 0) {
                const float* x = a.in[0];
                for (int m = gw; m < M; m += NGW) { const f32x4* xr = (const f32x4*)(x + (size_t)m * D) + lane; float s = 0.f; u32x2* o8 = (u32x2*)(XB + (size_t)m * D) + lane;
#pragma unroll
                    for (int j = 0; j < 4; ++j) { const f32x4 v = xr[64 * j]; s += (v[0] * v[0] + v[1] * v[1]) + (v[2] * v[2] + v[3] * v[3]); u32x2 w; w.x = pk2(v[0], v[1]); w.y = pk2(v[2], v[3]); o8[64 * j] = w; }
#pragma unroll
                    for (int o = 1; o < 64; o <<= 1) s += __shfl_xor(s, o);
                    if (lane == 0) *(f32x4*)(SS + (size_t)m * 4) = (f32x4){s, 0.f, 0.f, 0.f}; }
            }
            __syncthreads();
        } else if (k == 1 || k == 15) {
            pg8::Gemm g{XB, WB + (k == 1 ? O_W1IN : O_W2IN), M, 2 * F, D, D}; pg8::StaticOrder S; S.init(M, 2 * F, G, bid);
            pg8::EpiSwiglu E{H, SS + (size_t)(3 * l + (k == 1 ? 0 : 2)) * M * 4};
            pg8::gemm_phase<pg8::EpiSwiglu>(L, g, S, E);
        } else if (k == 2 || k == 16) {
            pg8::Gemm g{H, WB + (k == 2 ? O_W1OUT : O_W2OUT), M, D, F, F}; pg8::StaticOrder S; S.init(M, D, G, bid);
            const int sidx = 3 * l + (k == 2 ? 1 : 3);
            pg8::EpiResid E{(l == 0 && k == 2) ? a.in[0] : nullptr, XB, SS + (size_t)sidx * M * 4, 0.5f, (LAS float*)(L + 131072)};
            pg8::gemm_phase<pg8::EpiResid>(L, g, S, E);
        } else if (k == 8) {
            pg8::Gemm g{Mg, WB + O_WOUT, MH, D, D, ldg}; pg8::StaticOrder S; S.init(MH, D, G, bid);
            pg8::EpiResid E{nullptr, XB + rowoff * D, SS + (size_t)(3 * l + 2) * M * 4 + rowoff * 4, 1.0f, (LAS float*)(L + 131072)};
            pg8::gemm_phase<pg8::EpiResid>(L, g, S, E);
        } else if (k == 3) {
            pg8::Gemm g{XB + rowoff * D, WB + O_WIN, MH, PW, D, D}; pg8::StaticOrder S; S.init(MH, PW, G, bid);
            pg8::EpiInproj E{P, SS + (size_t)(3 * l + 1) * M * 4 + rowoff * 4};
            pg8::gemm_phase<pg8::EpiInproj>(L, g, S, E);
        } else if (k == 4) {
            int i = bid;
            for (; i < 2 * NCH; i += G) {
                if (i < NCH) unit_attn(L, P, a.in[10] + l * 8, i, tid);
                else unit_gmlp(L, P, WB + O_WS, a.in[7] + l * 512, a.in[9] + l * 512, i - NCH, tid);
            }
            if (i < 6 * NCH) {
                int tk = tid; asm volatile("" : "+v"(tk));
                KvRegs R; kv_load(R, P, i - 2 * NCH, tk);
                for (; i < 6 * NCH; i += G) { const int u = i - 2 * NCH;
                    kv_store(L, R, u, tk); __syncthreads();
                    if (i + G < 6 * NCH) kv_load(R, P, i + G - 2 * NCH, tk);
                    kv_compute(L, KV, u, tk); __syncthreads(); }
            }
        } else if (k == 5) {
            phase_scan(KV, bid * 512 + tid, G * 512);
        } else if (k == 6) {
            if (bid < 4 * NCH) { int tk = tid; asm volatile("" : "+v"(tk)); RetRegs R; ret_load(R, P, bid, tk);
                for (int i = bid; i < 4 * NCH; i += G) unit_ret(L, P, KV, a.in[11] + l * 1024, i, tid, R, (i + G < 4 * NCH) ? i + G : -1); }
        } else if (k == 7) {
            for (int br = 0; br < 3; ++br) {
                const int gi = (br == 0) ? 2 : (br - 1);
                if (2 * br >= MK_P7) break;
                {   pg8::Gemm g{XB + rowoff * D, WB + O_WIN + (size_t)(PW + gi * D) * D, MH, D, D, D}; pg8::StaticOrder S; S.init(MH, D, G, bid);
                    pg8::EpiGate E{Gt, SS + (size_t)(3 * l + 1) * M * 4 + rowoff * 4, a.in[6] + l * 3 * D + gi * D, ldg, (MK_X2) ? OUT + rowoff * D : nullptr};
                    pg8::gemm_phase<pg8::EpiGate>(L, g, S, E);
#if MK_T10
                    {
                        asm volatile("s_waitcnt vmcnt(0)" ::: "memory"); __syncthreads();
                        pg8::Unit uu; for (int ui = 0; S.next(ui, uu); ++ui)
                            for (int e = tid; e < 256 * 256; e += 512) { const int r = e >> 8, c = e & 255; const size_t row = (size_t)uu.pm * 256 + r, col = (size_t)uu.pn * 256 + c;
                                OUT[(rowoff + row) * D + col] = bflo((unsigned)Gt[row * ldg + col]); }
                    }
#endif
                }
                if (2 * br + 1 >= MK_P7) break;
                {   pg8::Gemm g; pg8::StaticOrder S; S.init(MH, D, G, bid);
                    if (br == 0) g = pg8::Gemm{P + C_CG, WB + O_WBC, MH, D, D, PW}; else if (br == 1) g = pg8::Gemm{P + C_AU, WB + O_WBA, MH, D, 512, PW}; else g = pg8::Gemm{P + C_BQ, WB + O_WBB, MH, D, 512, PW};
                    pg8::EpiMerge E{Gt, Mg, br == 0 ? 1 : 0, ldg};
                    pg8::gemm_phase<pg8::EpiMerge>(L, g, S, E); }
            }
        } else {
#if MK_X2 || MK_T10
            continue;
#endif
#ifdef MK_DBG
#if MK_DELAY
            { const unsigned long long t0 = __builtin_amdgcn_s_memrealtime(); while (__builtin_amdgcn_s_memrealtime() - t0 < 30000ull) __builtin_amdgcn_s_sleep(32); }
            __builtin_amdgcn_fence(__ATOMIC_ACQUIRE, "agent"); asm volatile("s_waitcnt vmcnt(0)" ::: "memory"); __syncthreads();
#endif
            {   const bf16_t* src16 = (MK_DBG == 1) ? Gt : Mg;
                for (size_t i = (size_t)bid * 512 + tid; i < (size_t)M * D; i += (size_t)G * 512) { const size_t m = i >> 10, c = i & 1023; OUT[i] = (m < (size_t)MH) ? bflo((unsigned)src16[m * ldg + c]) : 0.f; } }
            continue;
#endif
            const int gw = bid * 8 + wave, NGW = G * 8; const float* fg = a.in[19]; const float* ss = SS + (size_t)6 * M * 4;
            for (int m = gw; m < M; m += NGW) { f32x4* xr = (f32x4*)(OUT + (size_t)m * D) + lane; const u32x2* xs = (const u32x2*)(XB + (size_t)m * D) + lane; const float r = row_rstd(ss, m);
#pragma unroll
                for (int j = 0; j < 4; ++j) { const u32x2 bw = xs[64 * j]; const f32x4 v = (f32x4){bflo(bw.x), bfhi(bw.x), bflo(bw.y), bfhi(bw.y)}; const f32x4 gq = *((const f32x4*)fg + lane + 64 * j); xr[64 * j] = v * r * gq; } }
        }
        if (pidx + 1 < a.ph_hi) {
            xcd_barrier(xbar);
            if (a.ph_lo < 0) cg::this_grid().sync();
        }
    }
}

extern "C" void kernel_launch(void* const* d_in, const int* in_sizes, int n_in, void* d_out, int out_size, void* d_ws, size_t ws_size, hipStream_t stream) {
    static int grid = 0;
    if (grid == 0) {
        if (n_in != 20 || in_sizes[0] != M * D || out_size != M * D || ws_size < WS_END) { fprintf(stderr, "kernel_launch: unexpected shapes / workspace (n_in %d, ws %zu, need %zu)\n", n_in, ws_size, (size_t)WS_END); grid = -1; return; }
        int dev = 0, cus = 0, per_cu = 0;
        hipGetDevice(&dev); hipDeviceGetAttribute(&cus, hipDeviceAttributeMultiprocessorCount, dev);
        if (hipFuncSetAttribute((const void*)mk_fwd, hipFuncAttributeMaxDynamicSharedMemorySize, LDS_BYTES) != hipSuccess) { fprintf(stderr, "kernel_launch: hipFuncSetAttribute failed\n"); grid = -1; return; }
        if (hipOccupancyMaxActiveBlocksPerMultiprocessor(&per_cu, (const void*)mk_fwd, 512, LDS_BYTES) != hipSuccess || per_cu < 1) { fprintf(stderr, "kernel_launch: occupancy query says %d\n", per_cu); per_cu = 1; }
        (void)hipGetLastError();
        grid = cus * 1;
    }
    if (grid < 0) return;
    (void)hipMemsetAsync((char*)d_ws + WS_BAR, 0, 16384, stream);
    Args a{};
    for (int i = 0; i < 20; ++i) a.in[i] = (const float*)d_in[i];
    a.out = (float*)d_out; a.ws = (unsigned char*)d_ws;
#if MK_MULTI
    for (int i = 0; i < ((MK_STOP < NPHASES) ? MK_STOP + 1 : NPHASES); ++i) { const int ph = (MK_STOP < NPHASES && i == MK_STOP) ? NPHASES - 1 : i; a.ph_lo = ph; a.ph_hi = ph + 1; hipLaunchKernelGGL(mk_fwd, dim3(grid), dim3(512), LDS_BYTES, stream, a); }
#else
    a.ph_lo = 0; a.ph_hi = (MK_REPBLK) ? NPHASES + 4 : (MK_REPPH >= 0) ? NPHASES + 1 : ((MK_STOP < NPHASES) ? MK_STOP + 1 : NPHASES);
    void* args[] = {&a};
    hipError_t e = hipLaunchCooperativeKernel((const void*)mk_fwd, dim3(grid), dim3(512), args, LDS_BYTES, stream);
    if (e != hipSuccess) fprintf(stderr, "cooperative launch failed: %s (grid %d)\n", hipGetErrorString(e), grid);
#endif
}
```

```cpp
#include <hip/hip_runtime.h>
#include <hip/hip_cooperative_groups.h>
#include <cstdio>
#include <cstdint>
namespace cg = cooperative_groups;

#ifndef MK_DELAY
#define MK_DELAY 0
#endif
#define MK_WTG 0
#define MK_T10 0
#ifndef MK_EXTRASYNC
#define MK_EXTRASYNC 0
#endif
#ifndef MK_REPPH
#define MK_REPPH -1
#endif
#ifndef MK_FENCE
#define MK_FENCE 4
#endif
#ifndef MK_REPBLK
#define MK_REPBLK 0
#endif
#ifndef MK_GOVL
#define MK_GOVL 0
#endif
#ifndef MK_SCRUB
#define MK_SCRUB 0
#endif
#ifndef MK_WTIN
#define MK_WTIN 0
#endif
#ifndef MK_X3
#define MK_X3 0
#endif
#ifndef MK_X2
#define MK_X2 0
#endif
#ifndef MK_P7
#define MK_P7 6
#endif
#ifndef MK_CGSYNC
#define MK_CGSYNC 0
#endif
#ifndef MK_MULTI
#define MK_MULTI 0
#endif

#define LAS __attribute__((address_space(3)))
typedef unsigned short bf16_t;
typedef short bf16x8 __attribute__((ext_vector_type(8)));
typedef float f32x4 __attribute__((ext_vector_type(4)));
typedef float f32x2 __attribute__((ext_vector_type(2)));
typedef unsigned u32x4 __attribute__((ext_vector_type(4)));
typedef unsigned u32x2 __attribute__((ext_vector_type(2)));

constexpr int M = 32768, D = 1024, F = 2816, NCHUNK = 256, DEPTH = 2;
constexpr int PW = 4864;
constexpr int C_AU = 0, C_AV = 512, C_BQ = 1024, C_BK = 1536, C_BV = 1664, C_CQ = 1792, C_CK = 2304, C_CV = 2816, C_CG = 3840;
constexpr int C_GT = 1792;
constexpr int C_MG = 2816;
constexpr float NORM_EPS = 1e-6f, GN_EPS = 1e-5f, LOG2E = 1.4426950408889634f;
#ifndef MK_NB
#define MK_NB 1
#endif
constexpr int NB = MK_NB;
constexpr int MH = M / NB, NCH = MH / 128;
constexpr int NPH_LAYER = 5 + 6 * NB, NPHASES = NPH_LAYER * DEPTH + 1;

constexpr size_t MiB = 1u << 20;
constexpr size_t WS_BAR = 0;
constexpr size_t WS_WB = 1 * MiB;
constexpr size_t WS_XB = 57 * MiB;
constexpr size_t WS_P = 121 * MiB;
constexpr size_t WS_KV = WS_P + (size_t)MH * PW * 2;
constexpr size_t WS_G = WS_KV + (size_t)MH * 2048;
constexpr size_t WS_MG = WS_G + (NB == 2 ? 64 * MiB : 0);
constexpr size_t WS_SSP = WS_MG + (NB == 2 ? 64 * MiB : 0);
constexpr size_t WS_END = WS_SSP + 4 * MiB;
static_assert(WS_END <= 512 * MiB && WS_P + (size_t)M * F * 2 <= WS_G, "d_ws map");
constexpr size_t O_W1IN = 0, O_W1OUT = 5767168, O_WIN = 8650752, O_WBA = 16777216, O_WBB = 17301504, O_WBC = 17825792,
                 O_WOUT = 18874368, O_W2IN = 19922944, O_W2OUT = 25690112, O_WS = 28573696, O_WEND = 28639232;
static_assert(O_WEND * 2 <= 56 * MiB, "weights fit");

__device__ __forceinline__ float bflo(unsigned w) { return __uint_as_float(w << 16); }
__device__ __forceinline__ float bfhi(unsigned w) { return __uint_as_float(w & 0xffff0000u); }
__device__ __forceinline__ unsigned f2bf(float f) { unsigned u = __float_as_uint(f); return (u + 0x7fffu + ((u >> 16) & 1u)) >> 16; }
__device__ __forceinline__ unsigned pk2(float lo, float hi) { return f2bf(lo) | (f2bf(hi) << 16); }
__device__ __forceinline__ float fexp2(float x) { return __builtin_amdgcn_exp2f(x); }
__device__ __forceinline__ float frcp(float x) { return __builtin_amdgcn_rcpf(x); }
__device__ __forceinline__ float sigmoid_f(float x) { return frcp(1.0f + fexp2(-x * LOG2E)); }
__device__ __forceinline__ float silu_f(float x) { return x * sigmoid_f(x); }
__device__ __forceinline__ float gelu_tanh_f(float x) { const float u = 0.7978845608028654f * (x + 0.044715f * x * x * x); return x * frcp(1.0f + fexp2(-2.0f * LOG2E * u)); }

__device__ __forceinline__ void st16_wt(void* p, u32x4 v) { asm volatile("global_store_dwordx4 %0, %1, off sc0 sc1" :: "v"(p), "v"(v) : "memory"); }
__device__ __forceinline__ void st8_wt(void* p, u32x2 v) { asm volatile("global_store_dwordx2 %0, %1, off sc0 sc1" :: "v"(p), "v"(v) : "memory"); }
__device__ __forceinline__ void st4_wt(void* p, float v) { asm volatile("global_store_dword %0, %1, off sc0 sc1" :: "v"(p), "v"(v) : "memory"); }
__device__ __forceinline__ float row_rstd(const float* ssp, int row) { const f32x4 p = *(const f32x4*)(ssp + (size_t)row * 4); return rsqrtf(((p[0] + p[1]) + (p[2] + p[3])) * (1.0f / D) + NORM_EPS); }

namespace pg8 {
constexpr int BM = 256, BK = 64, HALF = 128, HTB = HALF * BK * 2, STAGE_BYTES = 8 * HTB, NXCD = 8, WGM = 8;
__host__ __device__ __forceinline__ int lds_byte(int r, int c) { const int st = (r >> 4) * 2 + (c >> 5), rr = r & 15, cc = c & 31, ob = rr * 64 + cc * 2; return st * 1024 + (ob ^ (((ob >> 9) & 1) << 5)); }
__host__ __device__ __forceinline__ void stage_rc(int b, int& R, int& C) { const int st = b / 1024, sb = b % 1024, swz = sb ^ (((sb >> 9) & 1) << 5); R = (st >> 1) * 16 + swz / 64; C = (st & 1) * 32 + (swz % 64) / 2; }
__host__ __device__ __forceinline__ int perm32(int rho) { const int n = rho >> 4, i = rho & 15; return 8 * (i >> 2) + 4 * n + (i & 3); }

struct Unit { int pm, pn; };
struct Gemm { const bf16_t* A; const bf16_t* Bt; int M, N, K, lda; };

struct StaticOrder {
    int nM, nN, nwg, G, c;
    __device__ void init(int M_, int N_, int G_, int c_) { nM = M_ / BM; nN = N_ / BM; nwg = nM * nN; G = G_; c = c_; }
    __device__ bool next(int i, Unit& u) const {
        const long L = (long)i * G + c; if (L >= nwg) return false;
        int wgid = (int)L; { const int q = nwg / NXCD, r = nwg % NXCD, xcd = wgid % NXCD, off = wgid / NXCD; wgid = (xcd < r ? xcd * (q + 1) : r * (q + 1) + (xcd - r) * q) + off; }
        const int nig = WGM * nN, gid = wgid / nig, fm = gid * WGM, gsz = (nM - fm) < WGM ? (nM - fm) : WGM;
        u.pm = fm + ((wgid % nig) % gsz); u.pn = (wgid % nig) / gsz; return true;
    }
};
typedef __bf16 bf16x2_t __attribute__((ext_vector_type(2)));
__device__ __forceinline__ unsigned cvt_pk_bf16(float lo, float hi) { const f32x2 v = {lo, hi}; const bf16x2_t b = __builtin_convertvector(v, bf16x2_t); return __builtin_bit_cast(unsigned, b); }

template <class Epi>
__device__ __forceinline__ void gemm_phase(LAS unsigned char* lds, const Gemm g, const StaticOrder& S, const Epi& E) {
    int tid = threadIdx.x; asm volatile("" : "+v"(tid));
    const int wid = __builtin_amdgcn_readfirstlane(tid >> 6), lane = tid & 63, wr = wid >> 2, wc = wid & 3, fr = lane & 15, fq = lane >> 4;
    const int K = g.K, nt = K / BK, lda = g.lda;
    unsigned voffA[2], voffB[2];
#pragma unroll
    for (int i = 0; i < 2; ++i) { int R, C; stage_rc(tid * 16 + i * 8192, R, C); const int Rb = Epi::PERM ? ((R & ~31) + perm32(R & 31)) : R;
        voffA[i] = (unsigned)(R * lda + C) * 2u; voffB[i] = (unsigned)(Rb * K + C) * 2u; }
    const size_t kstep = (size_t)(BK * 2);
    const size_t hstepA = (size_t)HALF * lda * 2, hstepB = (size_t)HALF * K * 2;
    const size_t tstepA = 2 * hstepA, tstepB = 2 * hstepB;
    const unsigned ldsw = (unsigned)wid * 1024u;
    const int aoff = lds_byte(wr * 64 + fr, fq * 8), boff = lds_byte(wc * 32 + fr, fq * 8);
#define PG8_SA(b, h) (((b) * 2 + (h)) * HTB)
#define PG8_SB(b, h) ((4 + (b) * 2 + (h)) * HTB)
#define PG8_STAGE(bufoff, gbase, voff) do { _Pragma("unroll") for (int _i = 0; _i < 2; ++_i) \
        __builtin_amdgcn_global_load_lds((const unsigned*)((const char*)(gbase) + (voff)[_i]), (LAS unsigned*)(lds + (bufoff) + ldsw + _i * 8192), 16, 0, 0); } while (0)
#define PG8_LDA(dst, b, h) do { _Pragma("unroll") for (int m = 0; m < 4; ++m) _Pragma("unroll") for (int k = 0; k < 2; ++k) dst[m][k] = *(const LAS bf16x8*)(lds + PG8_SA(b, h) + aoff + m * 2048 + k * 1024); } while (0)
#define PG8_LDB(dst, b, h) do { _Pragma("unroll") for (int n = 0; n < 2; ++n) _Pragma("unroll") for (int k = 0; k < 2; ++k) dst[n][k] = *(const LAS bf16x8*)(lds + PG8_SB(b, h) + boff + n * 2048 + k * 1024); } while (0)
#define PG8_MMA(ai, bj, At, Bt) do { __builtin_amdgcn_s_setprio(1); _Pragma("unroll") for (int m = 0; m < 4; ++m) _Pragma("unroll") for (int n = 0; n < 2; ++n) _Pragma("unroll") for (int k = 0; k < 2; ++k) \
        acc[ai][bj][m][n] = __builtin_amdgcn_mfma_f32_16x16x32_bf16(Bt[n][k], At[m][k], acc[ai][bj][m][n], 0, 0, 0); __builtin_amdgcn_s_setprio(0); } while (0)
#define PG8_WAIT_V(n) asm volatile("s_waitcnt vmcnt(" #n ")" ::: "memory")
#define PG8_WAIT_L(n) asm volatile("s_waitcnt lgkmcnt(" #n ")" ::: "memory")
#define PG8_BAR __builtin_amdgcn_s_barrier()
#define PG8_SCHED __builtin_amdgcn_sched_barrier(0)
    Unit cur, nxt; int ui = 0;
    if (!S.next(0, cur)) return;
    f32x4 acc[2][2][4][2];
#pragma unroll
    for (int a = 0; a < 2; ++a)
#pragma unroll
        for (int b = 0; b < 2; ++b)
#pragma unroll
            for (int m = 0; m < 4; ++m)
#pragma unroll
                for (int n = 0; n < 2; ++n) acc[a][b][m][n] = (f32x4){0.f, 0.f, 0.f, 0.f};
    bf16x8 At[4][2], B0[2][2], B1[2][2];
    const char* cA = (const char*)g.A + (size_t)cur.pm * tstepA; const char* cB = (const char*)g.Bt + (size_t)cur.pn * tstepB;
    PG8_STAGE(PG8_SB(0, 0), cB, voffB); PG8_STAGE(PG8_SB(0, 1), cB + hstepB, voffB); PG8_STAGE(PG8_SA(0, 0), cA, voffA); PG8_STAGE(PG8_SA(0, 1), cA + hstepA, voffA);
    if (wr == 1) PG8_BAR;
    PG8_WAIT_V(2); PG8_BAR;
    PG8_STAGE(PG8_SB(1, 0), cB + kstep, voffB); PG8_STAGE(PG8_SA(1, 0), cA + kstep, voffA); PG8_STAGE(PG8_SB(1, 1), cB + hstepB + kstep, voffB);
    PG8_WAIT_V(6); PG8_BAR;
    for (;;) {
        const bool has_next = S.next(ui + 1, nxt);
        const char* nA = has_next ? (const char*)g.A + (size_t)nxt.pm * tstepA : cA; const char* nB = has_next ? (const char*)g.Bt + (size_t)nxt.pn * tstepB : cB;
        for (int t = 0; t < nt; t += 2) {
            const bool last = (t == nt - 2);
            const char* a1 = cA + (size_t)(t + 1) * kstep;
            const char* a2 = last ? nA : cA + (size_t)(t + 2) * kstep; const char* b2 = last ? nB : cB + (size_t)(t + 2) * kstep;
            const char* a3 = a2 + kstep; const char* b3 = b2 + kstep;
            PG8_LDB(B0, 0, 0); PG8_LDB(B1, 0, 1); PG8_SCHED; PG8_LDA(At, 0, 0); PG8_STAGE(PG8_SA(1, 1), a1 + hstepA, voffA);
            PG8_WAIT_V(8); PG8_WAIT_L(0); PG8_BAR; PG8_MMA(0, 0, At, B0); PG8_MMA(0, 1, At, B1); PG8_BAR; PG8_SCHED;
            PG8_LDA(At, 0, 1); PG8_STAGE(PG8_SB(0, 0), b2, voffB); PG8_STAGE(PG8_SB(0, 1), b2 + hstepB, voffB); PG8_STAGE(PG8_SA(0, 0), a2, voffA);
            PG8_WAIT_V(8); PG8_WAIT_L(0); PG8_BAR; PG8_MMA(1, 0, At, B0); PG8_MMA(1, 1, At, B1); PG8_BAR; PG8_SCHED;
            PG8_LDB(B0, 1, 0); PG8_LDB(B1, 1, 1); PG8_SCHED; PG8_LDA(At, 1, 0); PG8_STAGE(PG8_SA(0, 1), a2 + hstepA, voffA);
            PG8_WAIT_V(8); PG8_WAIT_L(0); PG8_BAR; PG8_MMA(0, 0, At, B0); PG8_MMA(0, 1, At, B1); PG8_BAR; PG8_SCHED;
            PG8_LDA(At, 1, 1); PG8_STAGE(PG8_SB(1, 0), b3, voffB); PG8_STAGE(PG8_SB(1, 1), b3 + hstepB, voffB); PG8_STAGE(PG8_SA(1, 0), a3, voffA);
            PG8_WAIT_V(8); PG8_WAIT_L(0); PG8_BAR; PG8_MMA(1, 0, At, B0); PG8_MMA(1, 1, At, B1); PG8_BAR; PG8_SCHED;
        }
        if (wr == 0) PG8_BAR;
        E(acc, cur, wr, wc, fr, fq);
        if (!has_next) break;
#pragma unroll
        for (int a = 0; a < 2; ++a)
#pragma unroll
            for (int b = 0; b < 2; ++b)
#pragma unroll
                for (int m = 0; m < 4; ++m)
#pragma unroll
                    for (int n = 0; n < 2; ++n) acc[a][b][m][n] = (f32x4){0.f, 0.f, 0.f, 0.f};
        cur = nxt; cA = nA; cB = nB; ++ui;
        if (wr == 1) PG8_BAR;
    }
    PG8_WAIT_V(0);
    PG8_BAR;
#undef PG8_SA
#undef PG8_SB
#undef PG8_STAGE
#undef PG8_LDA
#undef PG8_LDB
#undef PG8_MMA
#undef PG8_WAIT_V
#undef PG8_WAIT_L
#undef PG8_BAR
#undef PG8_SCHED
}

struct EpiSwiglu {
    static constexpr bool PERM = true;
    bf16_t* H; const float* ss;
    __device__ __forceinline__ void operator()(const f32x4 (&acc)[2][2][4][2], const Unit& u, int wr, int wc, int fr, int fq) const {
        const int row0 = u.pm * BM + wr * 64 + fr, col0 = u.pn * 128 + wc * 32 + 8 * fq;
#pragma unroll
        for (int ai = 0; ai < 2; ++ai)
#pragma unroll
            for (int m = 0; m < 4; ++m) { const int row = row0 + ai * HALF + m * 16; const float r = row_rstd(ss, row);
                float h[8];
#pragma unroll
                for (int n = 0; n < 2; ++n)
#pragma unroll
                    for (int e = 0; e < 4; ++e) { const float a = acc[ai][0][m][n][e] * r, b = acc[ai][1][m][n][e] * r; h[n * 4 + e] = silu_f(a) * b; }
                u32x4 w; w.x = cvt_pk_bf16(h[0], h[1]); w.y = cvt_pk_bf16(h[2], h[3]); w.z = cvt_pk_bf16(h[4], h[5]); w.w = cvt_pk_bf16(h[6], h[7]);
                *(u32x4*)(H + (size_t)row * F + col0) = w; }
    }
};
struct EpiResid {
    static constexpr bool PERM = true;
    const float* base32; bf16_t* xb; float* ssn; float scale; LAS float* red;
    __device__ __forceinline__ void operator()(const f32x4 (&acc)[2][2][4][2], const Unit& u, int wr, int wc, int fr, int fq) const {
        const int row0 = u.pm * BM + wr * 64 + fr, col0 = u.pn * BM + wc * 32 + 8 * fq;
#pragma unroll
        for (int ai = 0; ai < 2; ++ai)
#pragma unroll
            for (int m = 0; m < 4; ++m) { const int row = row0 + ai * HALF + m * 16; const size_t off = (size_t)row * D + col0; float q = 0.f;
#pragma unroll
                for (int bj = 0; bj < 2; ++bj) { const size_t o2 = off + bj * HALF; f32x4 b0, b1;
                    if (base32) { b0 = *(const f32x4*)(base32 + o2); b1 = *(const f32x4*)(base32 + o2 + 4); }
                    else { const u32x4 bw = *(const u32x4*)(xb + o2); b0 = (f32x4){bflo(bw.x), bfhi(bw.x), bflo(bw.y), bfhi(bw.y)}; b1 = (f32x4){bflo(bw.z), bfhi(bw.z), bflo(bw.w), bfhi(bw.w)}; }
                    const f32x4 o0 = b0 + acc[ai][bj][m][0] * scale, o1 = b1 + acc[ai][bj][m][1] * scale;
                    u32x4 w; w.x = cvt_pk_bf16(o0[0], o0[1]); w.y = cvt_pk_bf16(o0[2], o0[3]); w.z = cvt_pk_bf16(o1[0], o1[1]); w.w = cvt_pk_bf16(o1[2], o1[3]);
                    *(u32x4*)(xb + o2) = w;
                    q += ((o0[0] * o0[0] + o0[1] * o0[1]) + (o0[2] * o0[2] + o0[3] * o0[3])) + ((o1[0] * o1[0] + o1[1] * o1[1]) + (o1[2] * o1[2] + o1[3] * o1[3])); }
                q += __shfl_xor(q, 16); q += __shfl_xor(q, 32);
                if (fq == 0) red[(ai * HALF + wr * 64 + m * 16 + fr) * 4 + wc] = q;
                if ((m & (MK_FENCE - 1)) == MK_FENCE - 1) asm volatile("" ::: "memory"); }
        asm volatile("s_waitcnt lgkmcnt(0)" ::: "memory"); __builtin_amdgcn_s_barrier(); asm volatile("" ::: "memory");
        if (wr == 0) { const int t = wc * 64 + fq * 16 + fr; const f32x4 p = *(const LAS f32x4*)(red + t * 4);
            ssn[((size_t)u.pm * BM + t) * 4 + u.pn] = (p[0] + p[1]) + (p[2] + p[3]); }
    }
};
struct EpiInproj {
    static constexpr bool PERM = true;
    bf16_t* P; const float* ss;
    __device__ __forceinline__ void operator()(const f32x4 (&acc)[2][2][4][2], const Unit& u, int wr, int wc, int fr, int fq) const {
        if (u.pn < 4) run<1>(acc, u, wr, wc, fr, fq); else if (u.pn >= 15) run<2>(acc, u, wr, wc, fr, fq); else run<0>(acc, u, wr, wc, fr, fq);
    }
    template <int ACT> __device__ __forceinline__ void run(const f32x4 (&acc)[2][2][4][2], const Unit& u, int wr, int wc, int fr, int fq) const {
        const int row0 = u.pm * BM + wr * 64 + fr, col0 = u.pn * BM + wc * 32 + 8 * fq;
#pragma unroll
        for (int ai = 0; ai < 2; ++ai)
#pragma unroll
            for (int m = 0; m < 4; ++m) { const int row = row0 + ai * HALF + m * 16; const float r = row_rstd(ss, row);
#pragma unroll
                for (int bj = 0; bj < 2; ++bj) { float h[8];
#pragma unroll
                    for (int n = 0; n < 2; ++n)
#pragma unroll
                        for (int e = 0; e < 4; ++e) { const float v = acc[ai][bj][m][n][e] * r; h[n * 4 + e] = (ACT == 1) ? gelu_tanh_f(v) : ((ACT == 2) ? silu_f(v) : v); }
                    u32x4 w; w.x = cvt_pk_bf16(h[0], h[1]); w.y = cvt_pk_bf16(h[2], h[3]); w.z = cvt_pk_bf16(h[4], h[5]); w.w = cvt_pk_bf16(h[6], h[7]);
#if MK_WTIN
                    asm volatile("global_store_dwordx4 %0, %1, off sc0 sc1" :: "v"(P + (size_t)row * PW + col0 + bj * HALF), "v"(w) : "memory"); } }
#else
                    *(u32x4*)(P + (size_t)row * PW + col0 + bj * HALF) = w; } }
#endif
    }
};
struct EpiGate {
    static constexpr bool PERM = true;
    bf16_t* G; const float* ss; const float* bias; int ld; float* dbg32;
    __device__ __forceinline__ void operator()(const f32x4 (&acc)[2][2][4][2], const Unit& u, int wr, int wc, int fr, int fq) const {
        const int row0 = u.pm * BM + wr * 64 + fr, col0 = u.pn * BM + wc * 32 + 8 * fq;
#pragma unroll
        for (int ai = 0; ai < 2; ++ai)
#pragma unroll
            for (int m = 0; m < 4; ++m) { const int row = row0 + ai * HALF + m * 16; const float r = row_rstd(ss, row);
#pragma unroll
                for (int bj = 0; bj < 2; ++bj) { float h[8]; const f32x4 b0 = *(const f32x4*)(bias + col0 + bj * HALF), b1 = *(const f32x4*)(bias + col0 + bj * HALF + 4);
#pragma unroll
#ifdef MK_X1
                    for (int e = 0; e < 4; ++e) { h[e] = sigmoid_f(acc[ai][bj][m][0][e] * 0.03f + 0.f * (r + b0[e])); h[4 + e] = sigmoid_f(acc[ai][bj][m][1][e] * 0.03f + 0.f * b1[e]); }
#else
                    for (int e = 0; e < 4; ++e) { h[e] = sigmoid_f(acc[ai][bj][m][0][e] * r + b0[e]); h[4 + e] = sigmoid_f(acc[ai][bj][m][1][e] * r + b1[e]); }
#endif
                    u32x4 w; w.x = cvt_pk_bf16(h[0], h[1]); w.y = cvt_pk_bf16(h[2], h[3]); w.z = cvt_pk_bf16(h[4], h[5]); w.w = cvt_pk_bf16(h[6], h[7]);
#if MK_WTG
                    asm volatile("global_store_dwordx4 %0, %1, off sc0 sc1" :: "v"(G + (size_t)row * ld + col0 + bj * HALF), "v"(w) : "memory");
#else
                    *(u32x4*)(G + (size_t)row * ld + col0 + bj * HALF) = w;
#endif
                    if (dbg32) { *(f32x4*)(dbg32 + (size_t)row * D + col0 + bj * HALF) = (f32x4){h[0], h[1], h[2], h[3]}; *(f32x4*)(dbg32 + (size_t)row * D + col0 + bj * HALF + 4) = (f32x4){h[4], h[5], h[6], h[7]}; } }
                if ((m & (MK_FENCE - 1)) == MK_FENCE - 1) asm volatile("" ::: "memory"); }
    }
};
struct EpiMerge {
    static constexpr bool PERM = true;
    const bf16_t* G; bf16_t* Mg; int first, ld;
    __device__ __forceinline__ void operator()(const f32x4 (&acc)[2][2][4][2], const Unit& u, int wr, int wc, int fr, int fq) const {
        const int row0 = u.pm * BM + wr * 64 + fr, col0 = u.pn * BM + wc * 32 + 8 * fq;
#pragma unroll
        for (int ai = 0; ai < 2; ++ai)
#pragma unroll
            for (int m = 0; m < 4; ++m) { const int row = row0 + ai * HALF + m * 16;
#pragma unroll
                for (int bj = 0; bj < 2; ++bj) { const size_t off = (size_t)row * ld + col0 + bj * HALF;
                    const u32x4 gv = *(const u32x4*)(G + off); u32x4 mv = (u32x4){0u, 0u, 0u, 0u}; if (!first) mv = *(const u32x4*)(Mg + off);
                    float h[8];
#pragma unroll
                    for (int n = 0; n < 2; ++n) { const unsigned g0 = n ? gv.z : gv.x, g1 = n ? gv.w : gv.y, m0 = n ? mv.z : mv.x, m1 = n ? mv.w : mv.y;
                        h[n * 4 + 0] = bflo(m0) + bflo(g0) * acc[ai][bj][m][n][0]; h[n * 4 + 1] = bfhi(m0) + bfhi(g0) * acc[ai][bj][m][n][1];
                        h[n * 4 + 2] = bflo(m1) + bflo(g1) * acc[ai][bj][m][n][2]; h[n * 4 + 3] = bfhi(m1) + bfhi(g1) * acc[ai][bj][m][n][3]; }
                    u32x4 w; w.x = cvt_pk_bf16(h[0], h[1]); w.y = cvt_pk_bf16(h[2], h[3]); w.z = cvt_pk_bf16(h[4], h[5]); w.w = cvt_pk_bf16(h[6], h[7]);
                    *(u32x4*)(Mg + off) = w; }
                if ((m & (MK_FENCE - 1)) == MK_FENCE - 1) asm volatile("" ::: "memory"); }
    }
};
}

template <int KSTEPS>
__device__ __forceinline__ f32x4 mma_k(const LAS unsigned char* pa, const LAS unsigned char* pb, f32x4 acc) {
#pragma unroll
    for (int s = 0; s < KSTEPS; ++s) { const bf16x8 a = *(const LAS bf16x8*)(pa + s * 64); const bf16x8 b = *(const LAS bf16x8*)(pb + s * 64);
        acc = __builtin_amdgcn_mfma_f32_16x16x32_bf16(a, b, acc, 0, 0, 0); }
    return acc;
}
typedef short v4i16 __attribute__((ext_vector_type(4)));
__device__ __forceinline__ bf16x8 ld_tr_frag(const LAS unsigned char* img, int pitch, int tok0, int ch0, int lane) {
    const int g = lane >> 4, q = (lane & 15) >> 2, p = lane & 3;
    const LAS unsigned char* a = img + (tok0 + 8 * g + q) * pitch + (ch0 + 4 * p) * 2;
    const v4i16 lo = __builtin_amdgcn_ds_read_tr16_b64_v4i16((LAS v4i16*)a);
    const v4i16 hi = __builtin_amdgcn_ds_read_tr16_b64_v4i16((LAS v4i16*)(a + 4 * pitch));
    return __builtin_shufflevector(lo, hi, 0, 1, 2, 3, 4, 5, 6, 7);
}
__device__ __forceinline__ void lds_st16(LAS unsigned char* p, unsigned v) { *(LAS unsigned short*)p = (unsigned short)v; }

__device__ __forceinline__ void unit_gmlp(LAS unsigned char* L, bf16_t* P, const bf16_t* WSb, const float* vnorm, const float* bs, int ci, int tid) {
    asm volatile("" : "+v"(tid));
    const int lane = tid & 63, wid = tid >> 6, l15 = lane & 15, lq = lane >> 4;
    constexpr int PT = 272;
    LAS unsigned char* Wl = L; LAS unsigned char* VT = L + 34816; LAS float* rs = (LAS float*)(L + 69632);
    bf16_t* Prow = P + (size_t)ci * 128 * PW;
    {
        const int t = tid >> 2, part = tid & 3; const bf16_t* src = Prow + (size_t)t * PW + C_AV + part * 128; float s = 0.f;
#pragma unroll 4
        for (int i = 0; i < 16; ++i) { const u32x4 v = *((const u32x4*)(src + 8 * i));
            s += bflo(v.x) * bflo(v.x) + bfhi(v.x) * bfhi(v.x) + bflo(v.y) * bflo(v.y) + bfhi(v.y) * bfhi(v.y) + bflo(v.z) * bflo(v.z) + bfhi(v.z) * bfhi(v.z) + bflo(v.w) * bflo(v.w) + bfhi(v.w) * bfhi(v.w); }
        s += __shfl_xor(s, 1); s += __shfl_xor(s, 2);
        if (part == 0) rs[t] = rsqrtf(s * (1.0f / 512.0f) + NORM_EPS);
    }
    __syncthreads();
    for (int g = 0; g < 4; ++g) {
        for (int i = tid; i < 2048; i += 512) { const int r = i >> 4, c = i & 15; *(LAS u32x4*)(Wl + r * PT + c * 16) = *((const u32x4*)(WSb + g * 16384 + r * 128 + c * 8)); }
        for (int i = tid; i < 2048; i += 512) { const int r = i >> 4, c = i & 15; const float rr = rs[r]; const float* gn = vnorm + g * 128 + c * 8;
            const u32x4 v = *((const u32x4*)(Prow + (size_t)r * PW + C_AV + g * 128 + c * 8)); const f32x4 g0 = *(const f32x4*)gn, g1 = *(const f32x4*)(gn + 4);
            u32x4 o; o.x = pk2(bflo(v.x) * rr * g0[0], bfhi(v.x) * rr * g0[1]); o.y = pk2(bflo(v.y) * rr * g0[2], bfhi(v.y) * rr * g0[3]);
            o.z = pk2(bflo(v.z) * rr * g1[0], bfhi(v.z) * rr * g1[1]); o.w = pk2(bflo(v.w) * rr * g1[2], bfhi(v.w) * rr * g1[3]);
            *(LAS u32x4*)(VT + r * PT + c * 16) = o; }
        __syncthreads();
        {   bf16x8 af[4];
#pragma unroll
            for (int s = 0; s < 4; ++s) af[s] = ld_tr_frag(VT, PT, 32 * s, 16 * wid, lane);
#pragma unroll
            for (int tt = 0; tt < 8; ++tt) { const LAS unsigned char* pb = Wl + (16 * tt + l15) * PT + lq * 16;
                f32x4 acc = (f32x4){0.f, 0.f, 0.f, 0.f};
#pragma unroll
                for (int s = 0; s < 4; ++s) acc = __builtin_amdgcn_mfma_f32_16x16x32_bf16(af[s], *(const LAS bf16x8*)(pb + s * 64), acc, 0, 0, 0);
                const int t = 16 * tt + l15, d = 16 * wid + 4 * lq; const float b = bs[g * 128 + t];
                bf16_t* up = Prow + (size_t)t * PW + C_AU + g * 128 + d; const u32x2 uv = *((const u32x2*)up);
                u32x2 o; o.x = pk2(bflo(uv.x) * (acc[0] + b), bfhi(uv.x) * (acc[1] + b)); o.y = pk2(bflo(uv.y) * (acc[2] + b), bfhi(uv.y) * (acc[3] + b));
                *(u32x2*)up = o; }
        }
        __syncthreads();
    }
}

__device__ __forceinline__ void unit_attn(LAS unsigned char* L, bf16_t* P, const float* sinks, int ci, int tid) {
    asm volatile("" : "+v"(tid));
    const int lane = tid & 63, wid = tid >> 6, l15 = lane & 15, lq = lane >> 4;
    constexpr int PK = 144, PV = 144, PP = 336;
    LAS unsigned char* Kl = L; LAS unsigned char* VT = L + 36864; LAS unsigned char* Pl = L + 73728 + wid * 5376;
    const int n = ci & 127; const long rowbase = (long)ci * 128 - 128;
    for (int kvh = 0; kvh < 2; ++kvh) {
        for (int i = tid; i < 2048; i += 512) { const int r = i >> 3, c = i & 7; u32x4 v = (u32x4){0u, 0u, 0u, 0u};
            if (n > 0 || r >= 128) v = *((const u32x4*)(P + (size_t)(rowbase + r) * PW + C_BK + kvh * 64 + c * 8));
            *(LAS u32x4*)(Kl + r * PK + c * 16) = v; }
        for (int i = tid; i < 2048; i += 512) { const int r = i >> 3, c = i & 7; u32x4 v = (u32x4){0u, 0u, 0u, 0u};
            if (n > 0 || r >= 128) v = *(const u32x4*)(P + (size_t)(rowbase + r) * PW + C_BV + kvh * 64 + c * 8);
            *(LAS u32x4*)(VT + r * PV + c * 16) = v; }
        __syncthreads();
        const bf16_t* qq0 = P + ((size_t)ci * 128 + 16 * ((wid & 1) * 4) + l15) * PW + C_BQ + (kvh * 4 + (wid >> 1)) * 64 + lq * 8;
        bf16x8 qn0 = *(const bf16x8*)qq0, qn1 = *(const bf16x8*)(qq0 + 32);
        for (int it = 0; it < 4; ++it) {
            const bf16x8 q0 = qn0, q1 = qn1;
            if (it < 3) { const bf16_t* qq = qq0 + (size_t)(16 * (it + 1)) * PW; qn0 = *(const bf16x8*)qq; qn1 = *(const bf16x8*)(qq + 32); }
            const int g = wid >> 1, qt = (wid & 1) * 4 + it, h = kvh * 4 + g;
            const float slope = fexp2(-(float)(h + 1)), sink = sinks[h];
            const size_t qrow = (size_t)ci * 128 + 16 * qt + l15;
            bf16_t* qp = P + qrow * PW + C_BQ + h * 64;
            const int kt0 = qt & ~1;
            f32x4 sc[10];
#pragma unroll
            for (int i = 0; i < 10; ++i) { const LAS unsigned char* pa = Kl + (16 * (kt0 + i) + l15) * PK + lq * 16;
                f32x4 a = __builtin_amdgcn_mfma_f32_16x16x32_bf16(*(const LAS bf16x8*)pa, q0, (f32x4){0.f, 0.f, 0.f, 0.f}, 0, 0, 0);
                sc[i] = __builtin_amdgcn_mfma_f32_16x16x32_bf16(*(const LAS bf16x8*)(pa + 64), q1, a, 0, 0, 0); }
            const int qpos = 128 + 16 * qt + l15; float mx = sink;
#pragma unroll
            for (int i = 0; i < 10; ++i)
#pragma unroll
                for (int j = 0; j < 4; ++j) { const int kpos = 16 * (kt0 + i) + 4 * lq + j, dist = qpos - kpos; const bool valid = dist >= 0 && dist < 128 && (n > 0 || kpos >= 128);
                    const float s = valid ? sc[i][j] * 0.125f - slope * (float)dist : -INFINITY; sc[i][j] = s; mx = fmaxf(mx, s); }
            mx = fmaxf(mx, __shfl_xor(mx, 16)); mx = fmaxf(mx, __shfl_xor(mx, 32));
            float sum = 0.f;
#pragma unroll
            for (int i = 0; i < 10; ++i)
#pragma unroll
                for (int j = 0; j < 4; ++j) { const float p = fexp2((sc[i][j] - mx) * LOG2E); sc[i][j] = p; sum += p; }
            sum += __shfl_xor(sum, 16); sum += __shfl_xor(sum, 32);
            sum += fexp2((sink - mx) * LOG2E);
            const float inv = 1.0f / sum;
#pragma unroll
            for (int i = 0; i < 10; ++i) { u32x2 w; w.x = pk2(sc[i][0] * inv, sc[i][1] * inv); w.y = pk2(sc[i][2] * inv, sc[i][3] * inv);
                *(LAS u32x2*)(Pl + l15 * PP + (16 * i + 4 * lq) * 2) = w; }
            asm volatile("s_waitcnt lgkmcnt(0)" ::: "memory");
#pragma unroll
            for (int dt = 0; dt < 4; ++dt) { f32x4 acc = (f32x4){0.f, 0.f, 0.f, 0.f};
#pragma unroll
                for (int s5 = 0; s5 < 5; ++s5) { const bf16x8 a = ld_tr_frag(VT, PV, 16 * kt0 + 32 * s5, 16 * dt, lane);
                    const bf16x8 b = *(const LAS bf16x8*)(Pl + l15 * PP + (32 * s5 + 8 * lq) * 2);
                    acc = __builtin_amdgcn_mfma_f32_16x16x32_bf16(a, b, acc, 0, 0, 0); }
                u32x2 o; o.x = pk2(acc[0], acc[1]); o.y = pk2(acc[2], acc[3]);
                *(u32x2*)(qp + 16 * dt + 4 * lq) = o; }
            asm volatile("s_waitcnt lgkmcnt(0)" ::: "memory");
        }
        __syncthreads();
    }
}

struct KvRegs { u32x4 v[8], k[4]; };
__device__ __forceinline__ void kv_load(KvRegs& R, const bf16_t* P, int u, int tid) {
    const int ci = u >> 2, h = u & 3; const bf16_t* Pr = P + (size_t)ci * 128 * PW;
#pragma unroll
    for (int j = 0; j < 8; ++j) { const int i = tid + 512 * j, r = i >> 5, c = i & 31; R.v[j] = *((const u32x4*)(Pr + (size_t)r * PW + C_CV + h * 256 + c * 8)); }
#pragma unroll
    for (int j = 0; j < 4; ++j) { const int i = tid + 512 * j, r = i >> 4, c = i & 15; R.k[j] = *((const u32x4*)(Pr + (size_t)r * PW + C_CK + h * 128 + c * 8)); }
}
__device__ __forceinline__ void kv_store(LAS unsigned char* L, const KvRegs& R, int u, int tid) {
    constexpr int PVI = 528, PKI = 272; LAS unsigned char* Vi = L; LAS unsigned char* Ki = L + 128 * PVI;
    const float lg = log2f(1.0f - exp2f(-5.0f - (float)(u & 3)));
#pragma unroll
    for (int j = 0; j < 8; ++j) { const int i = tid + 512 * j, r = i >> 5, c = i & 31; *(LAS u32x4*)(Vi + r * PVI + c * 16) = R.v[j]; }
#pragma unroll
    for (int j = 0; j < 4; ++j) { const int i = tid + 512 * j, r = i >> 4, c = i & 15; const float kw = 0.08838834764831845f * fexp2(lg * (float)(127 - r)); const u32x4 v = R.k[j];
        u32x4 o; o.x = pk2(bflo(v.x) * kw, bfhi(v.x) * kw); o.y = pk2(bflo(v.y) * kw, bfhi(v.y) * kw); o.z = pk2(bflo(v.z) * kw, bfhi(v.z) * kw); o.w = pk2(bflo(v.w) * kw, bfhi(v.w) * kw);
        *(LAS u32x4*)(Ki + r * PKI + c * 16) = o; }
}
__device__ __forceinline__ void kv_compute(LAS unsigned char* L, bf16_t* KV, int u, int tid) {
    const int lane = tid & 63, wid = tid >> 6, l15 = lane & 15, lq = lane >> 4;
    constexpr int PVI = 528, PKI = 272; const LAS unsigned char* Vi = L; const LAS unsigned char* Ki = L + 128 * PVI;
    bf16_t* out = KV + (size_t)u * 32768;
    bf16x8 bfr[2][4];
#pragma unroll
    for (int ee = 0; ee < 2; ++ee)
#pragma unroll
        for (int s = 0; s < 4; ++s) bfr[ee][s] = ld_tr_frag(Vi, PVI, 32 * s, 16 * (2 * wid + ee), lane);
#pragma unroll 2
    for (int dt = 0; dt < 8; ++dt) { bf16x8 af[4];
#pragma unroll
        for (int s = 0; s < 4; ++s) af[s] = ld_tr_frag(Ki, PKI, 32 * s, 16 * dt, lane);
#pragma unroll
        for (int ee = 0; ee < 2; ++ee) { f32x4 acc = (f32x4){0.f, 0.f, 0.f, 0.f};
#pragma unroll
            for (int s = 0; s < 4; ++s) acc = __builtin_amdgcn_mfma_f32_16x16x32_bf16(af[s], bfr[ee][s], acc, 0, 0, 0);
            u32x2 o; o.x = pk2(acc[0], acc[1]); o.y = pk2(acc[2], acc[3]);
            *(u32x2*)(out + (16 * (2 * wid + ee) + l15) * 128 + 16 * dt + 4 * lq) = o; } }
}

__device__ __forceinline__ void phase_scan(bf16_t* KV, int gtid, int gthreads) {
    for (int w = gtid; w < 65536 * (MH / 16384); w += gthreads) {
        const int b = w >> 16, h = (w >> 14) & 3, e2 = w & 16383;
        const float decay = exp2f(128.0f * log2f(1.0f - exp2f(-5.0f - (float)h)));
        float st0 = 0.f, st1 = 0.f;
        unsigned* base = (unsigned*)(KV + ((size_t)(b * 128) * 4 + h) * 32768) + e2;
        for (int n0 = 0; n0 < 128; n0 += 16) {
            unsigned v[16];
#pragma unroll
            for (int i = 0; i < 16; ++i) v[i] = *(base + (size_t)(n0 + i) * 4 * 16384);
#pragma unroll
            for (int i = 0; i < 16; ++i) { base[(size_t)(n0 + i) * 4 * 16384] = pk2(st0, st1);
                st0 = decay * st0 + bflo(v[i]); st1 = decay * st1 + bfhi(v[i]); }
        }
    }
}

struct RetRegs { u32x4 q[4], k[4]; };
__device__ __forceinline__ void ret_load(RetRegs& R, const bf16_t* P, int u, int tid) {
    const int ci = u >> 2, h = u & 3;
#pragma unroll
    for (int j = 0; j < 4; ++j) { const int i = tid + 512 * j, r = i >> 4, c = i & 15; const bf16_t* src = P + ((size_t)ci * 128 + r) * PW + h * 128 + c * 8;
        R.q[j] = *((const u32x4*)(src + C_CQ)); R.k[j] = *((const u32x4*)(src + C_CK)); }
}
__device__ __forceinline__ void unit_ret(LAS unsigned char* L, bf16_t* P, const bf16_t* KV, const float* gn, int u, int tid, RetRegs& RR, int u_next) {
    asm volatile("" : "+v"(tid));
    const int lane = tid & 63, wid = tid >> 6, l15 = lane & 15, lq = lane >> 4;
    constexpr int PT = 272, R = 34816;
    LAS unsigned char* Ql = L; LAS unsigned char* Kl = L + R; LAS unsigned char* Pl = L + 2 * R; LAS unsigned char* Sl = L + 3 * R;
    const int ci = u >> 2, h = u & 3; const size_t row0 = (size_t)ci * 128;
    const float lg = log2f(1.0f - exp2f(-5.0f - (float)h));
#pragma unroll
    for (int j = 0; j < 4; ++j) { const int i = tid + 512 * j, r = i >> 4, c = i & 15; *(LAS u32x4*)(Ql + r * PT + c * 16) = RR.q[j]; *(LAS u32x4*)(Kl + r * PT + c * 16) = RR.k[j]; }
    __syncthreads();
    const int t = 16 * wid + l15;
    u32x4 pv[4], ps[4];
#pragma unroll
    for (int j = 0; j < 4; ++j) { const int i = tid + 512 * j, r = i >> 4, c = i & 15;
        pv[j] = *((const u32x4*)(P + (row0 + r) * PW + C_CV + h * 256 + c * 8));
        ps[j] = *((const u32x4*)(KV + (size_t)u * 32768 + r * 128 + c * 8)); }
    {   const LAS unsigned char* pb = Ql + t * PT + lq * 16;
        for (int st = 0; st < 8; ++st) { f32x4 acc = (f32x4){0.f, 0.f, 0.f, 0.f};
            if (st <= wid) { const LAS unsigned char* pa = Kl + (16 * st + l15) * PT + lq * 16; acc = mma_k<4>(pa, pb, acc); }
            float v[4];
#pragma unroll
            for (int j = 0; j < 4; ++j) { const int s = 16 * st + 4 * lq + j; v[j] = (s <= t) ? acc[j] * 0.08838834764831845f * fexp2(lg * (float)(t - s)) : 0.f; }
            u32x2 w; w.x = pk2(v[0], v[1]); w.y = pk2(v[2], v[3]);
            *(LAS u32x2*)(Pl + t * PT + (16 * st + 4 * lq) * 2) = w; }
    }
    __syncthreads();
    f32x4 o[16];
    const float qw = fexp2(lg * (float)(t + 1));
#pragma unroll
    for (int hf = 0; hf < 2; ++hf) {
#pragma unroll
        for (int j = 0; j < 4; ++j) { const int i = tid + 512 * j, r = i >> 4, c = i & 15;
            *(LAS u32x4*)(Kl + r * PT + c * 16) = pv[j]; *(LAS u32x4*)(Sl + r * PT + c * 16) = ps[j]; }
        __syncthreads();
        if (hf == 0) {
#pragma unroll
            for (int j = 0; j < 4; ++j) { const int i = tid + 512 * j, r = i >> 4, c = i & 15;
                pv[j] = *((const u32x4*)(P + (row0 + r) * PW + C_CV + h * 256 + 128 + c * 8));
                ps[j] = *((const u32x4*)(KV + (size_t)u * 32768 + (128 + r) * 128 + c * 8)); } }
        const LAS unsigned char* pbP = Pl + t * PT + lq * 16; const LAS unsigned char* pbQ = Ql + t * PT + lq * 16;
#pragma unroll
        for (int et = 0; et < 8; ++et) { const LAS unsigned char* paS = Sl + (16 * et + l15) * PT + lq * 16;
            f32x4 ai = (f32x4){0.f, 0.f, 0.f, 0.f};
#pragma unroll
            for (int s = 0; s < 4; ++s) ai = __builtin_amdgcn_mfma_f32_16x16x32_bf16(ld_tr_frag(Kl, PT, 32 * s, 16 * et, lane), *(const LAS bf16x8*)(pbP + s * 64), ai, 0, 0, 0);
            const f32x4 ac = mma_k<4>(paS, pbQ, (f32x4){0.f, 0.f, 0.f, 0.f});
            o[hf * 8 + et] = ai + ac * qw; }
        __syncthreads();
    }
    if (u_next >= 0) ret_load(RR, P, u_next, tid);
    float sum = 0.f;
#pragma unroll
    for (int i = 0; i < 16; ++i) sum += (o[i][0] + o[i][1]) + (o[i][2] + o[i][3]);
    sum += __shfl_xor(sum, 16); sum += __shfl_xor(sum, 32);
    const float mean = sum * (1.0f / 256.0f); float var = 0.f;
#pragma unroll
    for (int i = 0; i < 16; ++i) { const f32x4 dd = o[i] - mean; var += (dd[0] * dd[0] + dd[1] * dd[1]) + (dd[2] * dd[2] + dd[3] * dd[3]); }
    var += __shfl_xor(var, 16); var += __shfl_xor(var, 32);
    const float rstd = rsqrtf(var * (1.0f / 256.0f) + GN_EPS);
#pragma unroll
    for (int i = 0; i < 16; ++i) { const int e = 16 * i + 4 * lq; bf16_t* gp = P + (row0 + t) * PW + C_CG + h * 256 + e; const u32x2 gv = *((const u32x2*)gp); const f32x4 gg = *(const f32x4*)(gn + h * 256 + e);
        u32x2 w; w.x = pk2((o[i][0] - mean) * rstd * gg[0] * bflo(gv.x), (o[i][1] - mean) * rstd * gg[1] * bfhi(gv.x));
        w.y = pk2((o[i][2] - mean) * rstd * gg[2] * bflo(gv.y), (o[i][3] - mean) * rstd * gg[3] * bfhi(gv.y));
        *(u32x2*)gp = w; if ((i & 7) == 7) asm volatile("" ::: "memory"); }
    __syncthreads();
}

__device__ __forceinline__ void transpose_item(const float* W, int K, int N, bf16_t* WT, const float* gk, bool swiglu, LAS float* scr, int item, int lane) {
    const int nblk = N / 64, kb = item / nblk, nb = item % nblk, k0 = 64 * kb, n0 = 64 * nb;
    const int kr = lane >> 4, nq = 4 * (lane & 15);
    f32x4 v[16];
#pragma unroll
    for (int i = 0; i < 16; ++i) v[i] = __builtin_nontemporal_load((const f32x4*)(W + (size_t)(k0 + 4 * i + kr) * N + n0 + nq));
#pragma unroll
    for (int i = 0; i < 16; ++i) { const int kk = 4 * i + kr; const float g = gk ? gk[k0 + kk] : 1.0f; LAS float* d = scr + kk * 65 + nq;
        d[0] = v[i][0] * g; d[1] = v[i][1] * g; d[2] = v[i][2] * g; d[3] = v[i][3] * g; }
    asm volatile("s_waitcnt lgkmcnt(0)" ::: "memory");
    int d0 = n0; if (swiglu) { const int bj = n0 / F, rem = n0 % F; d0 = 256 * (rem / 128) + 128 * bj + (rem % 128); }
    const int c = lane & 7;
#pragma unroll
    for (int j = 0; j < 8; ++j) { const int n = (lane >> 3) + 8 * j; const LAS float* s = scr + (8 * c) * 65 + n;
        u32x4 o; o.x = pk2(s[0 * 65], s[1 * 65]); o.y = pk2(s[2 * 65], s[3 * 65]); o.z = pk2(s[4 * 65], s[5 * 65]); o.w = pk2(s[6 * 65], s[7 * 65]);
        *(u32x4*)(WT + (size_t)(d0 + n) * K + k0 + 8 * c) = o; }
    asm volatile("s_waitcnt lgkmcnt(0)" ::: "memory");
}

#define XB_TMO      128
#define XB_XCNT(j)  (256  + 64 * (j))
#define XB_XSUB(j)  (1280 + 64 * (j))
#define XB_XGEN(j)  (2304 + 64 * (j))
#define XB_TOP      3328
#define XB_TOPGEN   3392
#define XCD_BAR_WORDS 3456
#define XB_SPIN_CAP (1u << 18)
__device__ __forceinline__ unsigned xb_ld(unsigned* p)              { return __hip_atomic_load(p, __ATOMIC_RELAXED, __HIP_MEMORY_SCOPE_AGENT); }
__device__ __forceinline__ unsigned xb_add(unsigned* p, unsigned v) { return __hip_atomic_fetch_add(p, v, __ATOMIC_RELAXED, __HIP_MEMORY_SCOPE_AGENT); }
__device__ __forceinline__ unsigned xb_xcc_id() { return (unsigned)__builtin_amdgcn_s_getreg((3 << 11) | 20) & 0xFu; }
#define XB_SPIN(cond, bar) do { unsigned _sp = 0; while (cond) { __builtin_amdgcn_s_sleep(1); \
    if ((++_sp & 255u) == 0u) { if (xb_ld(&(bar)[XB_TMO])) break; if (_sp > XB_SPIN_CAP) { atomicAdd(&(bar)[XB_TMO], 1u); break; } } } } while (0)
struct XcdBarrier { unsigned* bar; unsigned x; volatile LAS unsigned* st; };
__device__ __forceinline__ XcdBarrier xcd_barrier_post(unsigned* bar, volatile LAS unsigned* st) {
    XcdBarrier b; b.bar = bar; b.x = xb_xcc_id(); b.st = st;
    if (threadIdx.x == 0) (void)xb_add(&bar[XB_XCNT(b.x)], 1u);
    return b;
}
__device__ __forceinline__ void xcd_barrier_complete(unsigned* bar, unsigned x, unsigned& nloc, unsigned& nx) {
    const unsigned G = gridDim.x * gridDim.y * gridDim.z;
    unsigned sum, cnt, mine, sp = 0u;
    for (;;) {
        sum = 0u; cnt = 0u; mine = 0u;
#pragma unroll
        for (unsigned j = 0; j < 16; ++j) { const unsigned c = xb_ld(&bar[XB_XCNT(j)]); sum += c; cnt += (c > 0u) ? 1u : 0u; mine = (j == x) ? c : mine; }
        if (sum == G) break;
        __builtin_amdgcn_s_sleep(1);
        if ((++sp & 255u) == 0u) { if (xb_ld(&bar[XB_TMO])) break; if (sp > XB_SPIN_CAP) { atomicAdd(&bar[XB_TMO], 1u); break; } }
    }
    nloc = mine > 0u ? mine : 1u; nx = cnt > 0u ? cnt : 1u;
}
__device__ __forceinline__ void xcd_barrier(const XcdBarrier& b) {
    asm volatile("s_waitcnt vmcnt(0)" ::: "memory");
    __syncthreads();
    if (threadIdx.x == 0) {
        unsigned* bar = b.bar;
        __builtin_amdgcn_s_waitcnt(0);
        unsigned nloc = b.st[0], nx = b.st[1];
        if (nloc == 0u) { xcd_barrier_complete(bar, b.x, nloc, nx); b.st[0] = nloc; b.st[1] = nx; }
        const unsigned old = xb_add(&bar[XB_XSUB(b.x)], 1u);
        const unsigned gen = old / nloc;
        if (old + 1u == (gen + 1u) * nloc) {
            __builtin_amdgcn_fence(__ATOMIC_RELEASE, "agent");
            asm volatile("s_waitcnt vmcnt(0)" ::: "memory");
            const unsigned og = xb_add(&bar[XB_TOP], 1u);
            const unsigned tg = og / nx;
            if (og + 1u == (tg + 1u) * nx) xb_add(&bar[XB_TOPGEN], 1u);
            else XB_SPIN(xb_ld(&bar[XB_TOPGEN]) == tg, bar);
            __builtin_amdgcn_fence(__ATOMIC_ACQUIRE, "agent");
            xb_add(&bar[XB_XGEN(b.x)], 1u);
            asm volatile("s_waitcnt vmcnt(0)" ::: "memory");
        } else {
            XB_SPIN(xb_ld(&bar[XB_XGEN(b.x)]) == gen, bar);
            __builtin_amdgcn_fence(__ATOMIC_ACQUIRE, "agent");
            asm volatile("s_waitcnt vmcnt(0)" ::: "memory");
        }
    }
    __syncthreads();
}

struct Args { const float* in[20]; float* out; unsigned char* ws; int ph_lo, ph_hi; };

constexpr int LDS_BYTES = 147456;

__global__ void __launch_bounds__(512, 2) mk_fwd(Args a) {
    extern __shared__ __attribute__((aligned(16))) unsigned char lds_raw[];
    LAS unsigned char* L = (LAS unsigned char*)lds_raw;
    volatile LAS unsigned* xst = (volatile LAS unsigned*)(L + 131072 + 8192);
    if (threadIdx.x == 0) { xst[0] = 0u; xst[1] = 0u; }
    __syncthreads();
    const XcdBarrier xbar = xcd_barrier_post((unsigned*)(a.ws + WS_BAR), xst);
#ifndef MK_STOP
#define MK_STOP NPHASES
#endif
    for (int pidx = a.ph_lo; pidx < a.ph_hi; ++pidx) {
        const int ph = (MK_REPBLK) ? ((pidx > 6) ? pidx - 4 : pidx) : (MK_REPPH >= 0) ? ((pidx > MK_REPPH) ? pidx - 1 : pidx) : ((!MK_MULTI && MK_STOP < NPHASES && pidx == a.ph_hi - 1) ? NPHASES - 1 : pidx);
        int tid = threadIdx.x; asm volatile("" : "+v"(tid));
        int bid = blockIdx.x; asm volatile("" : "+s"(bid));
        unsigned char* ws = a.ws; asm volatile("" : "+s"(ws));
        const int lane = tid & 63, wave = __builtin_amdgcn_readfirstlane(tid >> 6);
        const int G = gridDim.x;
        float* SS = (float*)(ws + WS_SSP);
        bf16_t* WB = (bf16_t*)(ws + WS_WB);
        bf16_t* XB = (bf16_t*)(ws + WS_XB);
        bf16_t* KV = (bf16_t*)(ws + WS_KV);
        bf16_t* P = (bf16_t*)(ws + WS_P);
        bf16_t* H = P;
        float* OUT = a.out;
        const int l = ph / NPH_LAYER, k0 = (ph == NPHASES - 1) ? 99 : ph % NPH_LAYER;
        const bool inmix = (k0 >= 3 && k0 < 3 + 6 * NB);
        const int bsel = inmix ? (k0 - 3) / 6 : 0;
        const int k = inmix ? 3 + (k0 - 3) % 6 : (k0 == 3 + 6 * NB ? 15 : (k0 == 4 + 6 * NB ? 16 : k0));
        const size_t rowoff = (size_t)bsel * MH;
#if MK_GOVL || MK_NB == 1
        bf16_t* Gt = P + C_GT; bf16_t* Mg = P + C_MG; const int ldg = PW;
#else
        bf16_t* Gt = (bf16_t*)(ws + WS_G) + rowoff * D; bf16_t* Mg = (bf16_t*)(ws + WS_MG) + rowoff * D; const int ldg = D;
#endif
        if (k == 0) {
            int lane_o = lane; asm volatile("" : "+v"(lane_o));
            LAS float* scr = (LAS float*)(L + wave * 16640);
            const int gw = bid * 8 + wave, NGW = G * 8;
            for (int it = gw; it < 6976; it += NGW) {
                int r = it; const float* W; const float* gk = nullptr; bf16_t* WT; int K_, N_; bool sw = false;
                if (r < 1408) { W = a.in[2] + (size_t)l * D * 2 * F; K_ = D; N_ = 2 * F; WT = WB + O_W1IN; gk = a.in[1] + l * D; sw = true; }
                else if ((r -= 1408) < 704) { W = a.in[3] + (size_t)l * F * D; K_ = F; N_ = D; WT = WB + O_W1OUT; }
                else if ((r -= 704) < 1984) { W = a.in[5] + (size_t)l * D * 7936; K_ = D; N_ = 7936; WT = WB + O_WIN; gk = a.in[4] + l * D; }
                else if ((r -= 1984) < 128) { W = a.in[12] + (size_t)l * 512 * D; K_ = 512; N_ = D; WT = WB + O_WBA; }
                else if ((r -= 128) < 128) { W = a.in[13] + (size_t)l * 512 * D; K_ = 512; N_ = D; WT = WB + O_WBB; }
                else if ((r -= 128) < 256) { W = a.in[14] + (size_t)l * D * D; K_ = D; N_ = D; WT = WB + O_WBC; }
                else if ((r -= 256) < 256) { W = a.in[15] + (size_t)l * D * D; K_ = D; N_ = D; WT = WB + O_WOUT; }
                else if ((r -= 256) < 1408) { W = a.in[17] + (size_t)l * D * 2 * F; K_ = D; N_ = 2 * F; WT = WB + O_W2IN; gk = a.in[16] + l * D; sw = true; }
                else { r -= 1408; W = a.in[18] + (size_t)l * F * D; K_ = F; N_ = D; WT = WB + O_W2OUT; }
                transpose_item(W, K_, N_, WT, gk, sw, scr, r, lane_o);
            }
            {
                const float* wsrc = a.in[8] + (size_t)l * 65536;
                for (int i = bid * 512 + tid; i < 65536; i += G * 512) { const int tt = (i >> 7) & 127, s = i & 127; WB[O_WS + i] = (bf16_t)f2bf(s <= tt ? wsrc[i] : 0.f); }
            }
            if (l == 0) {
                const float* x = a.in[0];
                for (int m = gw; m < M; m += NGW) { const f32x4* xr = (const f32x4*)(x + (size_t)m * D) + lane; float s = 0.f; u32x2* o8 = (u32x2*)(XB + (size_t)m * D) + lane;
#pragma unroll
                    for (int j = 0; j < 4; ++j) { const f32x4 v = __builtin_nontemporal_load(xr + 64 * j); s += (v[0] * v[0] + v[1] * v[1]) + (v[2] * v[2] + v[3] * v[3]); u32x2 w; w.x = pk2(v[0], v[1]); w.y = pk2(v[2], v[3]); o8[64 * j] = w; }
#pragma unroll
                    for (int o = 1; o < 64; o <<= 1) s += __shfl_xor(s, o);
                    if (lane == 0) *(f32x4*)(SS + (size_t)m * 4) = (f32x4){s, 0.f, 0.f, 0.f}; }
            }
            __syncthreads();
        } else if (k == 1 || k == 15) {
            pg8::Gemm g{XB, WB + (k == 1 ? O_W1IN : O_W2IN), M, 2 * F, D, D}; pg8::StaticOrder S; S.init(M, 2 * F, G, bid);
            pg8::EpiSwiglu E{H, SS + (size_t)(3 * l + (k == 1 ? 0 : 2)) * M * 4};
            pg8::gemm_phase<pg8::EpiSwiglu>(L, g, S, E);
        } else if (k == 2 || k == 16) {
            pg8::Gemm g{H, WB + (k == 2 ? O_W1OUT : O_W2OUT), M, D, F, F}; pg8::StaticOrder S; S.init(M, D, G, bid);
            const int sidx = 3 * l + (k == 2 ? 1 : 3);
            pg8::EpiResid E{(l == 0 && k == 2) ? a.in[0] : nullptr, XB, SS + (size_t)sidx * M * 4, 0.5f, (LAS float*)(L + 131072)};
            pg8::gemm_phase<pg8::EpiResid>(L, g, S, E);
        } else if (k == 8) {
            pg8::Gemm g{Mg, WB + O_WOUT, MH, D, D, ldg}; pg8::StaticOrder S; S.init(MH, D, G, bid);
            pg8::EpiResid E{nullptr, XB + rowoff * D, SS + (size_t)(3 * l + 2) * M * 4 + rowoff * 4, 1.0f, (LAS float*)(L + 131072)};
            pg8::gemm_phase<pg8::EpiResid>(L, g, S, E);
        } else if (k == 3) {
            pg8::Gemm g{XB + rowoff * D, WB + O_WIN, MH, PW, D, D}; pg8::StaticOrder S; S.init(MH, PW, G, bid);
            pg8::EpiInproj E{P, SS + (size_t)(3 * l + 1) * M * 4 + rowoff * 4};
            pg8::gemm_phase<pg8::EpiInproj>(L, g, S, E);
        } else if (k == 4) {
            int i = bid;
            for (; i < 2 * NCH; i += G) {
                if (i < NCH) unit_attn(L, P, a.in[10] + l * 8, i, tid);
                else unit_gmlp(L, P, WB + O_WS, a.in[7] + l * 512, a.in[9] + l * 512, i - NCH, tid);
            }
            if (i < 6 * NCH) {
                int tk = tid; asm volatile("" : "+v"(tk));
                KvRegs R; kv_load(R, P, i - 2 * NCH, tk);
                for (; i < 6 * NCH; i += G) { const int u = i - 2 * NCH;
                    kv_store(L, R, u, tk); __syncthreads();
                    if (i + G < 6 * NCH) kv_load(R, P, i + G - 2 * NCH, tk);
                    kv_compute(L, KV, u, tk); __syncthreads(); }
            }
        } else if (k == 5) {
            phase_scan(KV, bid * 512 + tid, G * 512);
        } else if (k == 6) {
            if (bid < 4 * NCH) { int tk = tid; asm volatile("" : "+v"(tk)); RetRegs R; ret_load(R, P, bid, tk);
                for (int i = bid; i < 4 * NCH; i += G) unit_ret(L, P, KV, a.in[11] + l * 1024, i, tid, R, (i + G < 4 * NCH) ? i + G : -1); }
        } else if (k == 7) {
            for (int br = 0; br < 3; ++br) {
                const int gi = (br == 0) ? 2 : (br - 1);
                if (2 * br >= MK_P7) break;
                {   pg8::Gemm g{XB + rowoff * D, WB + O_WIN + (size_t)(PW + gi * D) * D, MH, D, D, D}; pg8::StaticOrder S; S.init(MH, D, G, bid);
                    pg8::EpiGate E{Gt, SS + (size_t)(3 * l + 1) * M * 4 + rowoff * 4, a.in[6] + l * 3 * D + gi * D, ldg, (MK_X2) ? OUT + rowoff * D : nullptr};
                    pg8::gemm_phase<pg8::EpiGate>(L, g, S, E);
#if MK_T10
                    {
                        asm volatile("s_waitcnt vmcnt(0)" ::: "memory"); __syncthreads();
                        pg8::Unit uu; for (int ui = 0; S.next(ui, uu); ++ui)
                            for (int e = tid; e < 256 * 256; e += 512) { const int r = e >> 8, c = e & 255; const size_t row = (size_t)uu.pm * 256 + r, col = (size_t)uu.pn * 256 + c;
                                OUT[(rowoff + row) * D + col] = bflo((unsigned)Gt[row * ldg + col]); }
                    }
#endif
                }
                if (2 * br + 1 >= MK_P7) break;
                {   pg8::Gemm g; pg8::StaticOrder S; S.init(MH, D, G, bid);
                    if (br == 0) g = pg8::Gemm{P + C_CG, WB + O_WBC, MH, D, D, PW}; else if (br == 1) g = pg8::Gemm{P + C_AU, WB + O_WBA, MH, D, 512, PW}; else g = pg8::Gemm{P + C_BQ, WB + O_WBB, MH, D, 512, PW};
                    pg8::EpiMerge E{Gt, Mg, br == 0 ? 1 : 0, ldg};
                    pg8::gemm_phase<pg8::EpiMerge>(L, g, S, E); }
            }
        } else {
#if MK_X2 || MK_T10
            continue;
#endif
#ifdef MK_DBG
#if MK_DELAY
            { const unsigned long long t0 = __builtin_amdgcn_s_memrealtime(); while (__builtin_amdgcn_s_memrealtime() - t0 < 30000ull) __builtin_amdgcn_s_sleep(32); }
            __builtin_amdgcn_fence(__ATOMIC_ACQUIRE, "agent"); asm volatile("s_waitcnt vmcnt(0)" ::: "memory"); __syncthreads();
#endif
            {   const bf16_t* src16 = (MK_DBG == 1) ? Gt : Mg;
                for (size_t i = (size_t)bid * 512 + tid; i < (size_t)M * D; i += (size_t)G * 512) { const size_t m = i >> 10, c = i & 1023; OUT[i] = (m < (size_t)MH) ? bflo((unsigned)src16[m * ldg + c]) : 0.f; } }
            continue;
#endif
            const int gw = bid * 8 + wave, NGW = G * 8; const float* fg = a.in[19]; const float* ss = SS + (size_t)6 * M * 4;
            for (int m = gw; m < M; m += NGW) { f32x4* xr = (f32x4*)(OUT + (size_t)m * D) + lane; const u32x2* xs = (const u32x2*)(XB + (size_t)m * D) + lane; const float r = row_rstd(ss, m);
#pragma unroll
                for (int j = 0; j < 4; ++j) { const u32x2 bw = xs[64 * j]; const f32x4 v = (f32x4){bflo(bw.x), bfhi(bw.x), bflo(bw.y), bfhi(bw.y)}; const f32x4 gq = *((const f32x4*)fg + lane + 64 * j); xr[64 * j] = v * r * gq; } }
        }
        if (pidx + 1 < a.ph_hi) {
            xcd_barrier(xbar);
            if (pidx == a.ph_lo) { asm volatile("s_waitcnt vmcnt(0) lgkmcnt(0)" ::: "memory"); __syncthreads(); cg::this_grid().sync();
                __builtin_amdgcn_fence(__ATOMIC_ACQUIRE, "agent"); asm volatile("s_waitcnt vmcnt(0)" ::: "memory"); __syncthreads(); }
        }
    }
}

extern "C" void kernel_launch(void* const* d_in, const int* in_sizes, int n_in, void* d_out, int out_size, void* d_ws, size_t ws_size, hipStream_t stream) {
    static int grid = 0;
    if (grid == 0) {
        if (n_in != 20 || in_sizes[0] != M * D || out_size != M * D || ws_size < WS_END) { fprintf(stderr, "kernel_launch: unexpected shapes / workspace (n_in %d, ws %zu, need %zu)\n", n_in, ws_size, (size_t)WS_END); grid = -1; return; }
        int dev = 0, cus = 0, per_cu = 0;
        hipGetDevice(&dev); hipDeviceGetAttribute(&cus, hipDeviceAttributeMultiprocessorCount, dev);
        if (hipFuncSetAttribute((const void*)mk_fwd, hipFuncAttributeMaxDynamicSharedMemorySize, LDS_BYTES) != hipSuccess) { fprintf(stderr, "kernel_launch: hipFuncSetAttribute failed\n"); grid = -1; return; }
        if (hipOccupancyMaxActiveBlocksPerMultiprocessor(&per_cu, (const void*)mk_fwd, 512, LDS_BYTES) != hipSuccess || per_cu < 1) { fprintf(stderr, "kernel_launch: occupancy query says %d\n", per_cu); per_cu = 1; }
        (void)hipGetLastError();
        grid = cus * 1;
    }
    if (grid < 0) return;
    (void)hipMemsetAsync((char*)d_ws + WS_BAR, 0, 16384, stream);
    Args a{};
    for (int i = 0; i < 20; ++i) a.in[i] = (const float*)d_in[i];
    a.out = (float*)d_out; a.ws = (unsigned char*)d_ws;
#if MK_MULTI
    for (int i = 0; i < ((MK_STOP < NPHASES) ? MK_STOP + 1 : NPHASES); ++i) { const int ph = (MK_STOP < NPHASES && i == MK_STOP) ? NPHASES - 1 : i; a.ph_lo = ph; a.ph_hi = ph + 1; hipLaunchKernelGGL(mk_fwd, dim3(grid), dim3(512), LDS_BYTES, stream, a); }
#else
    a.ph_lo = 0; a.ph_hi = (MK_REPBLK) ? NPHASES + 4 : (MK_REPPH >= 0) ? NPHASES + 1 : ((MK_STOP < NPHASES) ? MK_STOP + 1 : NPHASES);
    void* args[] = {&a};
    hipError_t e = hipLaunchCooperativeKernel((const void*)mk_fwd, dim3(grid), dim3(512), args, LDS_BYTES, stream);
    if (e != hipSuccess) fprintf(stderr, "cooperative launch failed: %s (grid %d)\n", hipGetErrorString(e), grid);
#endif
}
```

```cpp
#include <hip/hip_runtime.h>
#include <hip/hip_cooperative_groups.h>
#include <cstdio>
#include <cstdint>
namespace cg = cooperative_groups;

#ifndef MK_DELAY
#define MK_DELAY 0
#endif
#define MK_WTG 0
#define MK_T10 0
#ifndef MK_EXTRASYNC
#define MK_EXTRASYNC 0
#endif
#ifndef MK_REPPH
#define MK_REPPH -1
#endif
#ifndef MK_FENCE
#define MK_FENCE 4
#endif
#ifndef MK_REPBLK
#define MK_REPBLK 0
#endif
#ifndef MK_GOVL
#define MK_GOVL 0
#endif
#ifndef MK_SCRUB
#define MK_SCRUB 0
#endif
#ifndef MK_WTIN
#define MK_WTIN 0
#endif
#ifndef MK_X3
#define MK_X3 0
#endif
#ifndef MK_X2
#define MK_X2 0
#endif
#ifndef MK_P7
#define MK_P7 6
#endif
#ifndef MK_CGSYNC
#define MK_CGSYNC 0
#endif
#ifndef MK_MULTI
#define MK_MULTI 0
#endif

#define LAS __attribute__((address_space(3)))
typedef unsigned short bf16_t;
typedef short bf16x8 __attribute__((ext_vector_type(8)));
typedef float f32x4 __attribute__((ext_vector_type(4)));
typedef float f32x2 __attribute__((ext_vector_type(2)));
typedef unsigned u32x4 __attribute__((ext_vector_type(4)));
typedef unsigned u32x2 __attribute__((ext_vector_type(2)));

constexpr int M = 32768, D = 1024, F = 2816, NCHUNK = 256, DEPTH = 2;
constexpr int PW = 4864;
constexpr int C_AU = 0, C_AV = 512, C_BQ = 1024, C_BK = 1536, C_BV = 1664, C_CQ = 1792, C_CK = 2304, C_CV = 2816, C_CG = 3840;
constexpr int C_GT = 1792;
constexpr int C_MG = 2816;
constexpr float NORM_EPS = 1e-6f, GN_EPS = 1e-5f, LOG2E = 1.4426950408889634f;
#ifndef MK_NB
#define MK_NB 1
#endif
constexpr int NB = MK_NB;
constexpr int MH = M / NB, NCH = MH / 128;
constexpr int NPH_LAYER = 5 + 6 * NB, NPHASES = NPH_LAYER * DEPTH + 1;

constexpr size_t MiB = 1u << 20;
constexpr size_t WS_BAR = 0;
constexpr size_t WS_WB = 1 * MiB;
constexpr size_t WS_XB = 57 * MiB;
constexpr size_t WS_P = 121 * MiB;
constexpr size_t WS_KV = WS_P + (size_t)MH * PW * 2;
constexpr size_t WS_G = WS_KV + (size_t)MH * 2048;
constexpr size_t WS_MG = WS_G + (NB == 2 ? 64 * MiB : 0);
constexpr size_t WS_SSP = WS_MG + (NB == 2 ? 64 * MiB : 0);
constexpr size_t WS_END = WS_SSP + 4 * MiB;
static_assert(WS_END <= 512 * MiB && WS_P + (size_t)M * F * 2 <= WS_G, "d_ws map");
constexpr size_t O_W1IN = 0, O_W1OUT = 5767168, O_WIN = 8650752, O_WBA = 16777216, O_WBB = 17301504, O_WBC = 17825792,
                 O_WOUT = 18874368, O_W2IN = 19922944, O_W2OUT = 25690112, O_WS = 28573696, O_WEND = 28639232;
static_assert(O_WEND * 2 <= 56 * MiB, "weights fit");

__device__ __forceinline__ float bflo(unsigned w) { return __uint_as_float(w << 16); }
__device__ __forceinline__ float bfhi(unsigned w) { return __uint_as_float(w & 0xffff0000u); }
__device__ __forceinline__ unsigned f2bf(float f) { unsigned u = __float_as_uint(f); return (u + 0x7fffu + ((u >> 16) & 1u)) >> 16; }
__device__ __forceinline__ unsigned pk2(float lo, float hi) { return f2bf(lo) | (f2bf(hi) << 16); }
__device__ __forceinline__ float fexp2(float x) { return __builtin_amdgcn_exp2f(x); }
__device__ __forceinline__ float frcp(float x) { return __builtin_amdgcn_rcpf(x); }
__device__ __forceinline__ float sigmoid_f(float x) { return frcp(1.0f + fexp2(-x * LOG2E)); }
__device__ __forceinline__ float silu_f(float x) { return x * sigmoid_f(x); }
__device__ __forceinline__ float gelu_tanh_f(float x) { const float u = 0.7978845608028654f * (x + 0.044715f * x * x * x); return x * frcp(1.0f + fexp2(-2.0f * LOG2E * u)); }

__device__ __forceinline__ void st16_wt(void* p, u32x4 v) { asm volatile("global_store_dwordx4 %0, %1, off sc0 sc1" :: "v"(p), "v"(v) : "memory"); }
__device__ __forceinline__ void st8_wt(void* p, u32x2 v) { asm volatile("global_store_dwordx2 %0, %1, off sc0 sc1" :: "v"(p), "v"(v) : "memory"); }
__device__ __forceinline__ void st4_wt(void* p, float v) { asm volatile("global_store_dword %0, %1, off sc0 sc1" :: "v"(p), "v"(v) : "memory"); }
__device__ __forceinline__ float row_rstd(const float* ssp, int row) { const f32x4 p = *(const f32x4*)(ssp + (size_t)row * 4); return rsqrtf(((p[0] + p[1]) + (p[2] + p[3])) * (1.0f / D) + NORM_EPS); }

namespace pg8 {
constexpr int BM = 256, BK = 64, HALF = 128, HTB = HALF * BK * 2, STAGE_BYTES = 8 * HTB, NXCD = 8, WGM = 8;
__host__ __device__ __forceinline__ int lds_byte(int r, int c) { const int st = (r >> 4) * 2 + (c >> 5), rr = r & 15, cc = c & 31, ob = rr * 64 + cc * 2; return st * 1024 + (ob ^ (((ob >> 9) & 1) << 5)); }
__host__ __device__ __forceinline__ void stage_rc(int b, int& R, int& C) { const int st = b / 1024, sb = b % 1024, swz = sb ^ (((sb >> 9) & 1) << 5); R = (st >> 1) * 16 + swz / 64; C = (st & 1) * 32 + (swz % 64) / 2; }
__host__ __device__ __forceinline__ int perm32(int rho) { const int n = rho >> 4, i = rho & 15; return 8 * (i >> 2) + 4 * n + (i & 3); }

struct Unit { int pm, pn; };
struct Gemm { const bf16_t* A; const bf16_t* Bt; int M, N, K, lda; };

struct StaticOrder {
    int nM, nN, nwg, G, c;
    __device__ void init(int M_, int N_, int G_, int c_) { nM = M_ / BM; nN = N_ / BM; nwg = nM * nN; G = G_; c = c_; }
    __device__ bool next(int i, Unit& u) const {
        const long L = (long)i * G + c; if (L >= nwg) return false;
        int wgid = (int)L; { const int q = nwg / NXCD, r = nwg % NXCD, xcd = wgid % NXCD, off = wgid / NXCD; wgid = (xcd < r ? xcd * (q + 1) : r * (q + 1) + (xcd - r) * q) + off; }
        const int nig = WGM * nN, gid = wgid / nig, fm = gid * WGM, gsz = (nM - fm) < WGM ? (nM - fm) : WGM;
        u.pm = fm + ((wgid % nig) % gsz); u.pn = (wgid % nig) / gsz; return true;
    }
};
typedef __bf16 bf16x2_t __attribute__((ext_vector_type(2)));
__device__ __forceinline__ unsigned cvt_pk_bf16(float lo, float hi) { const f32x2 v = {lo, hi}; const bf16x2_t b = __builtin_convertvector(v, bf16x2_t); return __builtin_bit_cast(unsigned, b); }

template <class Epi>
__device__ __forceinline__ void gemm_phase(LAS unsigned char* lds, const Gemm g, const StaticOrder& S, const Epi& E) {
    int tid = threadIdx.x; asm volatile("" : "+v"(tid));
    const int wid = __builtin_amdgcn_readfirstlane(tid >> 6), lane = tid & 63, wr = wid >> 2, wc = wid & 3, fr = lane & 15, fq = lane >> 4;
    const int K = g.K, nt = K / BK, lda = g.lda;
    unsigned voffA[2], voffB[2];
#pragma unroll
    for (int i = 0; i < 2; ++i) { int R, C; stage_rc(tid * 16 + i * 8192, R, C); const int Rb = Epi::PERM ? ((R & ~31) + perm32(R & 31)) : R;
        voffA[i] = (unsigned)(R * lda + C) * 2u; voffB[i] = (unsigned)(Rb * K + C) * 2u; }
    const size_t kstep = (size_t)(BK * 2);
    const size_t hstepA = (size_t)HALF * lda * 2, hstepB = (size_t)HALF * K * 2;
    const size_t tstepA = 2 * hstepA, tstepB = 2 * hstepB;
    const unsigned ldsw = (unsigned)wid * 1024u;
    const int aoff = lds_byte(wr * 64 + fr, fq * 8), boff = lds_byte(wc * 32 + fr, fq * 8);
#define PG8_SA(b, h) (((b) * 2 + (h)) * HTB)
#define PG8_SB(b, h) ((4 + (b) * 2 + (h)) * HTB)
#define PG8_STAGE(bufoff, gbase, voff) do { _Pragma("unroll") for (int _i = 0; _i < 2; ++_i) \
        __builtin_amdgcn_global_load_lds((const unsigned*)((const char*)(gbase) + (voff)[_i]), (LAS unsigned*)(lds + (bufoff) + ldsw + _i * 8192), 16, 0, 0); } while (0)
#define PG8_LDA(dst, b, h) do { _Pragma("unroll") for (int m = 0; m < 4; ++m) _Pragma("unroll") for (int k = 0; k < 2; ++k) dst[m][k] = *(const LAS bf16x8*)(lds + PG8_SA(b, h) + aoff + m * 2048 + k * 1024); } while (0)
#define PG8_LDB(dst, b, h) do { _Pragma("unroll") for (int n = 0; n < 2; ++n) _Pragma("unroll") for (int k = 0; k < 2; ++k) dst[n][k] = *(const LAS bf16x8*)(lds + PG8_SB(b, h) + boff + n * 2048 + k * 1024); } while (0)
#define PG8_MMA(ai, bj, At, Bt) do { __builtin_amdgcn_s_setprio(1); _Pragma("unroll") for (int m = 0; m < 4; ++m) _Pragma("unroll") for (int n = 0; n < 2; ++n) _Pragma("unroll") for (int k = 0; k < 2; ++k) \
        acc[ai][bj][m][n] = __builtin_amdgcn_mfma_f32_16x16x32_bf16(Bt[n][k], At[m][k], acc[ai][bj][m][n], 0, 0, 0); __builtin_amdgcn_s_setprio(0); } while (0)
#define PG8_WAIT_V(n) asm volatile("s_waitcnt vmcnt(" #n ")" ::: "memory")
#define PG8_WAIT_L(n) asm volatile("s_waitcnt lgkmcnt(" #n ")" ::: "memory")
#define PG8_BAR __builtin_amdgcn_s_barrier()
#define PG8_SCHED __builtin_amdgcn_sched_barrier(0)
    Unit cur, nxt; int ui = 0;
    if (!S.next(0, cur)) return;
    f32x4 acc[2][2][4][2];
#pragma unroll
    for (int a = 0; a < 2; ++a)
#pragma unroll
        for (int b = 0; b < 2; ++b)
#pragma unroll
            for (int m = 0; m < 4; ++m)
#pragma unroll
                for (int n = 0; n < 2; ++n) acc[a][b][m][n] = (f32x4){0.f, 0.f, 0.f, 0.f};
    bf16x8 At[4][2], B0[2][2], B1[2][2];
    const char* cA = (const char*)g.A + (size_t)cur.pm * tstepA; const char* cB = (const char*)g.Bt + (size_t)cur.pn * tstepB;
    PG8_STAGE(PG8_SB(0, 0), cB, voffB); PG8_STAGE(PG8_SB(0, 1), cB + hstepB, voffB); PG8_STAGE(PG8_SA(0, 0), cA, voffA); PG8_STAGE(PG8_SA(0, 1), cA + hstepA, voffA);
    if (wr == 1) PG8_BAR;
    PG8_WAIT_V(2); PG8_BAR;
    PG8_STAGE(PG8_SB(1, 0), cB + kstep, voffB); PG8_STAGE(PG8_SA(1, 0), cA + kstep, voffA); PG8_STAGE(PG8_SB(1, 1), cB + hstepB + kstep, voffB);
    PG8_WAIT_V(6); PG8_BAR;
    for (;;) {
        const bool has_next = S.next(ui + 1, nxt);
        const char* nA = has_next ? (const char*)g.A + (size_t)nxt.pm * tstepA : cA; const char* nB = has_next ? (const char*)g.Bt + (size_t)nxt.pn * tstepB : cB;
        for (int t = 0; t < nt; t += 2) {
            const bool last = (t == nt - 2);
            const char* a1 = cA + (size_t)(t + 1) * kstep;
            const char* a2 = last ? nA : cA + (size_t)(t + 2) * kstep; const char* b2 = last ? nB : cB + (size_t)(t + 2) * kstep;
            const char* a3 = a2 + kstep; const char* b3 = b2 + kstep;
            PG8_LDB(B0, 0, 0); PG8_LDB(B1, 0, 1); PG8_SCHED; PG8_LDA(At, 0, 0); PG8_STAGE(PG8_SA(1, 1), a1 + hstepA, voffA);
            PG8_WAIT_V(8); PG8_WAIT_L(0); PG8_BAR; PG8_MMA(0, 0, At, B0); PG8_MMA(0, 1, At, B1); PG8_BAR; PG8_SCHED;
            PG8_LDA(At, 0, 1); PG8_STAGE(PG8_SB(0, 0), b2, voffB); PG8_STAGE(PG8_SB(0, 1), b2 + hstepB, voffB); PG8_STAGE(PG8_SA(0, 0), a2, voffA);
            PG8_WAIT_V(8); PG8_WAIT_L(0); PG8_BAR; PG8_MMA(1, 0, At, B0); PG8_MMA(1, 1, At, B1); PG8_BAR; PG8_SCHED;
            PG8_LDB(B0, 1, 0); PG8_LDB(B1, 1, 1); PG8_SCHED; PG8_LDA(At, 1, 0); PG8_STAGE(PG8_SA(0, 1), a2 + hstepA, voffA);
            PG8_WAIT_V(8); PG8_WAIT_L(0); PG8_BAR; PG8_MMA(0, 0, At, B0); PG8_MMA(0, 1, At, B1); PG8_BAR; PG8_SCHED;
            PG8_LDA(At, 1, 1); PG8_STAGE(PG8_SB(1, 0), b3, voffB); PG8_STAGE(PG8_SB(1, 1), b3 + hstepB, voffB); PG8_STAGE(PG8_SA(1, 0), a3, voffA);
            PG8_WAIT_V(8); PG8_WAIT_L(0); PG8_BAR; PG8_MMA(1, 0, At, B0); PG8_MMA(1, 1, At, B1); PG8_BAR; PG8_SCHED;
        }
        if (wr == 0) PG8_BAR;
        E(acc, cur, wr, wc, fr, fq);
        if (!has_next) break;
#pragma unroll
        for (int a = 0; a < 2; ++a)
#pragma unroll
            for (int b = 0; b < 2; ++b)
#pragma unroll
                for (int m = 0; m < 4; ++m)
#pragma unroll
                    for (int n = 0; n < 2; ++n) acc[a][b][m][n] = (f32x4){0.f, 0.f, 0.f, 0.f};
        cur = nxt; cA = nA; cB = nB; ++ui;
        if (wr == 1) PG8_BAR;
    }
    PG8_WAIT_V(0);
    PG8_BAR;
#undef PG8_SA
#undef PG8_SB
#undef PG8_STAGE
#undef PG8_LDA
#undef PG8_LDB
#undef PG8_MMA
#undef PG8_WAIT_V
#undef PG8_WAIT_L
#undef PG8_BAR
#undef PG8_SCHED
}

struct EpiSwiglu {
    static constexpr bool PERM = true;
    bf16_t* H; const float* ss;
    __device__ __forceinline__ void operator()(const f32x4 (&acc)[2][2][4][2], const Unit& u, int wr, int wc, int fr, int fq) const {
        const int row0 = u.pm * BM + wr * 64 + fr, col0 = u.pn * 128 + wc * 32 + 8 * fq;
#pragma unroll
        for (int ai = 0; ai < 2; ++ai)
#pragma unroll
            for (int m = 0; m < 4; ++m) { const int row = row0 + ai * HALF + m * 16; const float r = row_rstd(ss, row);
                float h[8];
#pragma unroll
                for (int n = 0; n < 2; ++n)
#pragma unroll
                    for (int e = 0; e < 4; ++e) { const float a = acc[ai][0][m][n][e] * r, b = acc[ai][1][m][n][e] * r; h[n * 4 + e] = silu_f(a) * b; }
                u32x4 w; w.x = cvt_pk_bf16(h[0], h[1]); w.y = cvt_pk_bf16(h[2], h[3]); w.z = cvt_pk_bf16(h[4], h[5]); w.w = cvt_pk_bf16(h[6], h[7]);
                *(u32x4*)(H + (size_t)row * F + col0) = w; }
    }
};
struct EpiResid {
    static constexpr bool PERM = true;
    const float* base32; bf16_t* xb; float* ssn; float scale; LAS float* red;
    __device__ __forceinline__ void operator()(const f32x4 (&acc)[2][2][4][2], const Unit& u, int wr, int wc, int fr, int fq) const {
        const int row0 = u.pm * BM + wr * 64 + fr, col0 = u.pn * BM + wc * 32 + 8 * fq;
#pragma unroll
        for (int ai = 0; ai < 2; ++ai)
#pragma unroll
            for (int m = 0; m < 4; ++m) { const int row = row0 + ai * HALF + m * 16; const size_t off = (size_t)row * D + col0; float q = 0.f;
#pragma unroll
                for (int bj = 0; bj < 2; ++bj) { const size_t o2 = off + bj * HALF; f32x4 b0, b1;
                    if (base32) { b0 = __builtin_nontemporal_load((const f32x4*)(base32 + o2)); b1 = __builtin_nontemporal_load((const f32x4*)(base32 + o2 + 4)); }
                    else { const u32x4 bw = *(const u32x4*)(xb + o2); b0 = (f32x4){bflo(bw.x), bfhi(bw.x), bflo(bw.y), bfhi(bw.y)}; b1 = (f32x4){bflo(bw.z), bfhi(bw.z), bflo(bw.w), bfhi(bw.w)}; }
                    const f32x4 o0 = b0 + acc[ai][bj][m][0] * scale, o1 = b1 + acc[ai][bj][m][1] * scale;
                    u32x4 w; w.x = cvt_pk_bf16(o0[0], o0[1]); w.y = cvt_pk_bf16(o0[2], o0[3]); w.z = cvt_pk_bf16(o1[0], o1[1]); w.w = cvt_pk_bf16(o1[2], o1[3]);
                    *(u32x4*)(xb + o2) = w;
                    q += ((o0[0] * o0[0] + o0[1] * o0[1]) + (o0[2] * o0[2] + o0[3] * o0[3])) + ((o1[0] * o1[0] + o1[1] * o1[1]) + (o1[2] * o1[2] + o1[3] * o1[3])); }
                q += __shfl_xor(q, 16); q += __shfl_xor(q, 32);
                if (fq == 0) red[(ai * HALF + wr * 64 + m * 16 + fr) * 4 + wc] = q;
                if ((m & (MK_FENCE - 1)) == MK_FENCE - 1) asm volatile("" ::: "memory"); }
        asm volatile("s_waitcnt lgkmcnt(0)" ::: "memory"); __builtin_amdgcn_s_barrier(); asm volatile("" ::: "memory");
        if (wr == 0) { const int t = wc * 64 + fq * 16 + fr; const f32x4 p = *(const LAS f32x4*)(red + t * 4);
            ssn[((size_t)u.pm * BM + t) * 4 + u.pn] = (p[0] + p[1]) + (p[2] + p[3]); }
    }
};
struct EpiInproj {
    static constexpr bool PERM = true;
    bf16_t* P; const float* ss;
    __device__ __forceinline__ void operator()(const f32x4 (&acc)[2][2][4][2], const Unit& u, int wr, int wc, int fr, int fq) const {
        if (u.pn < 4) run<1>(acc, u, wr, wc, fr, fq); else if (u.pn >= 15) run<2>(acc, u, wr, wc, fr, fq); else run<0>(acc, u, wr, wc, fr, fq);
    }
    template <int ACT> __device__ __forceinline__ void run(const f32x4 (&acc)[2][2][4][2], const Unit& u, int wr, int wc, int fr, int fq) const {
        const int row0 = u.pm * BM + wr * 64 + fr, col0 = u.pn * BM + wc * 32 + 8 * fq;
#pragma unroll
        for (int ai = 0; ai < 2; ++ai)
#pragma unroll
            for (int m = 0; m < 4; ++m) { const int row = row0 + ai * HALF + m * 16; const float r = row_rstd(ss, row);
#pragma unroll
                for (int bj = 0; bj < 2; ++bj) { float h[8];
#pragma unroll
                    for (int n = 0; n < 2; ++n)
#pragma unroll
                        for (int e = 0; e < 4; ++e) { const float v = acc[ai][bj][m][n][e] * r; h[n * 4 + e] = (ACT == 1) ? gelu_tanh_f(v) : ((ACT == 2) ? silu_f(v) : v); }
                    u32x4 w; w.x = cvt_pk_bf16(h[0], h[1]); w.y = cvt_pk_bf16(h[2], h[3]); w.z = cvt_pk_bf16(h[4], h[5]); w.w = cvt_pk_bf16(h[6], h[7]);
#if MK_WTIN
                    asm volatile("global_store_dwordx4 %0, %1, off sc0 sc1" :: "v"(P + (size_t)row * PW + col0 + bj * HALF), "v"(w) : "memory"); } }
#else
                    *(u32x4*)(P + (size_t)row * PW + col0 + bj * HALF) = w; } }
#endif
    }
};
struct EpiGate {
    static constexpr bool PERM = true;
    bf16_t* G; const float* ss; const float* bias; int ld; float* dbg32;
    __device__ __forceinline__ void operator()(const f32x4 (&acc)[2][2][4][2], const Unit& u, int wr, int wc, int fr, int fq) const {
        const int row0 = u.pm * BM + wr * 64 + fr, col0 = u.pn * BM + wc * 32 + 8 * fq;
#pragma unroll
        for (int ai = 0; ai < 2; ++ai)
#pragma unroll
            for (int m = 0; m < 4; ++m) { const int row = row0 + ai * HALF + m * 16; const float r = row_rstd(ss, row);
#pragma unroll
                for (int bj = 0; bj < 2; ++bj) { float h[8]; const f32x4 b0 = *(const f32x4*)(bias + col0 + bj * HALF), b1 = *(const f32x4*)(bias + col0 + bj * HALF + 4);
#pragma unroll
#ifdef MK_X1
                    for (int e = 0; e < 4; ++e) { h[e] = sigmoid_f(acc[ai][bj][m][0][e] * 0.03f + 0.f * (r + b0[e])); h[4 + e] = sigmoid_f(acc[ai][bj][m][1][e] * 0.03f + 0.f * b1[e]); }
#else
                    for (int e = 0; e < 4; ++e) { h[e] = sigmoid_f(acc[ai][bj][m][0][e] * r + b0[e]); h[4 + e] = sigmoid_f(acc[ai][bj][m][1][e] * r + b1[e]); }
#endif
                    u32x4 w; w.x = cvt_pk_bf16(h[0], h[1]); w.y = cvt_pk_bf16(h[2], h[3]); w.z = cvt_pk_bf16(h[4], h[5]); w.w = cvt_pk_bf16(h[6], h[7]);
#if MK_WTG
                    asm volatile("global_store_dwordx4 %0, %1, off sc0 sc1" :: "v"(G + (size_t)row * ld + col0 + bj * HALF), "v"(w) : "memory");
#else
                    *(u32x4*)(G + (size_t)row * ld + col0 + bj * HALF) = w;
#endif
                    if (dbg32) { *(f32x4*)(dbg32 + (size_t)row * D + col0 + bj * HALF) = (f32x4){h[0], h[1], h[2], h[3]}; *(f32x4*)(dbg32 + (size_t)row * D + col0 + bj * HALF + 4) = (f32x4){h[4], h[5], h[6], h[7]}; } }
                if ((m & (MK_FENCE - 1)) == MK_FENCE - 1) asm volatile("" ::: "memory"); }
    }
};
struct EpiMerge {
    static constexpr bool PERM = true;
    const bf16_t* G; bf16_t* Mg; int first, ld;
    __device__ __forceinline__ void operator()(const f32x4 (&acc)[2][2][4][2], const Unit& u, int wr, int wc, int fr, int fq) const {
        const int row0 = u.pm * BM + wr * 64 + fr, col0 = u.pn * BM + wc * 32 + 8 * fq;
#pragma unroll
        for (int ai = 0; ai < 2; ++ai)
#pragma unroll
            for (int m = 0; m < 4; ++m) { const int row = row0 + ai * HALF + m * 16;
#pragma unroll
                for (int bj = 0; bj < 2; ++bj) { const size_t off = (size_t)row * ld + col0 + bj * HALF;
                    const u32x4 gv = *(const u32x4*)(G + off); u32x4 mv = (u32x4){0u, 0u, 0u, 0u}; if (!first) mv = *(const u32x4*)(Mg + off);
                    float h[8];
#pragma unroll
                    for (int n = 0; n < 2; ++n) { const unsigned g0 = n ? gv.z : gv.x, g1 = n ? gv.w : gv.y, m0 = n ? mv.z : mv.x, m1 = n ? mv.w : mv.y;
                        h[n * 4 + 0] = bflo(m0) + bflo(g0) * acc[ai][bj][m][n][0]; h[n * 4 + 1] = bfhi(m0) + bfhi(g0) * acc[ai][bj][m][n][1];
                        h[n * 4 + 2] = bflo(m1) + bflo(g1) * acc[ai][bj][m][n][2]; h[n * 4 + 3] = bfhi(m1) + bfhi(g1) * acc[ai][bj][m][n][3]; }
                    u32x4 w; w.x = cvt_pk_bf16(h[0], h[1]); w.y = cvt_pk_bf16(h[2], h[3]); w.z = cvt_pk_bf16(h[4], h[5]); w.w = cvt_pk_bf16(h[6], h[7]);
                    *(u32x4*)(Mg + off) = w; }
                if ((m & (MK_FENCE - 1)) == MK_FENCE - 1) asm volatile("" ::: "memory"); }
    }
};
}

template <int KSTEPS>
__device__ __forceinline__ f32x4 mma_k(const LAS unsigned char* pa, const LAS unsigned char* pb, f32x4 acc) {
#pragma unroll
    for (int s = 0; s < KSTEPS; ++s) { const bf16x8 a = *(const LAS bf16x8*)(pa + s * 64); const bf16x8 b = *(const LAS bf16x8*)(pb + s * 64);
        acc = __builtin_amdgcn_mfma_f32_16x16x32_bf16(a, b, acc, 0, 0, 0); }
    return acc;
}
typedef short v4i16 __attribute__((ext_vector_type(4)));
__device__ __forceinline__ bf16x8 ld_tr_frag(const LAS unsigned char* img, int pitch, int tok0, int ch0, int lane) {
    const int g = lane >> 4, q = (lane & 15) >> 2, p = lane & 3;
    const LAS unsigned char* a = img + (tok0 + 8 * g + q) * pitch + (ch0 + 4 * p) * 2;
    const v4i16 lo = __builtin_amdgcn_ds_read_tr16_b64_v4i16((LAS v4i16*)a);
    const v4i16 hi = __builtin_amdgcn_ds_read_tr16_b64_v4i16((LAS v4i16*)(a + 4 * pitch));
    return __builtin_shufflevector(lo, hi, 0, 1, 2, 3, 4, 5, 6, 7);
}
__device__ __forceinline__ void lds_st16(LAS unsigned char* p, unsigned v) { *(LAS unsigned short*)p = (unsigned short)v; }

__device__ __forceinline__ void unit_gmlp(LAS unsigned char* L, bf16_t* P, const bf16_t* WSb, const float* vnorm, const float* bs, int ci, int tid) {
    asm volatile("" : "+v"(tid));
    const int lane = tid & 63, wid = tid >> 6, l15 = lane & 15, lq = lane >> 4;
    constexpr int PT = 272;
    LAS unsigned char* Wl = L; LAS unsigned char* VT = L + 34816; LAS float* rs = (LAS float*)(L + 69632);
    bf16_t* Prow = P + (size_t)ci * 128 * PW;
    {
        const int t = tid >> 2, part = tid & 3; const bf16_t* src = Prow + (size_t)t * PW + C_AV + part * 128; float s = 0.f;
#pragma unroll 4
        for (int i = 0; i < 16; ++i) { const u32x4 v = *((const u32x4*)(src + 8 * i));
            s += bflo(v.x) * bflo(v.x) + bfhi(v.x) * bfhi(v.x) + bflo(v.y) * bflo(v.y) + bfhi(v.y) * bfhi(v.y) + bflo(v.z) * bflo(v.z) + bfhi(v.z) * bfhi(v.z) + bflo(v.w) * bflo(v.w) + bfhi(v.w) * bfhi(v.w); }
        s += __shfl_xor(s, 1); s += __shfl_xor(s, 2);
        if (part == 0) rs[t] = rsqrtf(s * (1.0f / 512.0f) + NORM_EPS);
    }
    __syncthreads();
    for (int g = 0; g < 4; ++g) {
        for (int i = tid; i < 2048; i += 512) { const int r = i >> 4, c = i & 15; *(LAS u32x4*)(Wl + r * PT + c * 16) = *((const u32x4*)(WSb + g * 16384 + r * 128 + c * 8)); }
        for (int i = tid; i < 2048; i += 512) { const int r = i >> 4, c = i & 15; const float rr = rs[r]; const float* gn = vnorm + g * 128 + c * 8;
            const u32x4 v = *((const u32x4*)(Prow + (size_t)r * PW + C_AV + g * 128 + c * 8)); const f32x4 g0 = *(const f32x4*)gn, g1 = *(const f32x4*)(gn + 4);
            u32x4 o; o.x = pk2(bflo(v.x) * rr * g0[0], bfhi(v.x) * rr * g0[1]); o.y = pk2(bflo(v.y) * rr * g0[2], bfhi(v.y) * rr * g0[3]);
            o.z = pk2(bflo(v.z) * rr * g1[0], bfhi(v.z) * rr * g1[1]); o.w = pk2(bflo(v.w) * rr * g1[2], bfhi(v.w) * rr * g1[3]);
            *(LAS u32x4*)(VT + r * PT + c * 16) = o; }
        __syncthreads();
        {   bf16x8 af[4];
#pragma unroll
            for (int s = 0; s < 4; ++s) af[s] = ld_tr_frag(VT, PT, 32 * s, 16 * wid, lane);
#pragma unroll
            for (int tt = 0; tt < 8; ++tt) { const LAS unsigned char* pb = Wl + (16 * tt + l15) * PT + lq * 16;
                f32x4 acc = (f32x4){0.f, 0.f, 0.f, 0.f};
#pragma unroll
                for (int s = 0; s < 4; ++s) acc = __builtin_amdgcn_mfma_f32_16x16x32_bf16(af[s], *(const LAS bf16x8*)(pb + s * 64), acc, 0, 0, 0);
                const int t = 16 * tt + l15, d = 16 * wid + 4 * lq; const float b = bs[g * 128 + t];
                bf16_t* up = Prow + (size_t)t * PW + C_AU + g * 128 + d; const u32x2 uv = *((const u32x2*)up);
                u32x2 o; o.x = pk2(bflo(uv.x) * (acc[0] + b), bfhi(uv.x) * (acc[1] + b)); o.y = pk2(bflo(uv.y) * (acc[2] + b), bfhi(uv.y) * (acc[3] + b));
                *(u32x2*)up = o; }
        }
        __syncthreads();
    }
}

__device__ __forceinline__ void unit_attn(LAS unsigned char* L, bf16_t* P, const float* sinks, int ci, int tid) {
    asm volatile("" : "+v"(tid));
    const int lane = tid & 63, wid = tid >> 6, l15 = lane & 15, lq = lane >> 4;
    constexpr int PK = 144, PV = 144, PP = 336;
    LAS unsigned char* Kl = L; LAS unsigned char* VT = L + 36864; LAS unsigned char* Pl = L + 73728 + wid * 5376;
    const int n = ci & 127; const long rowbase = (long)ci * 128 - 128;
    for (int kvh = 0; kvh < 2; ++kvh) {
        for (int i = tid; i < 2048; i += 512) { const int r = i >> 3, c = i & 7; u32x4 v = (u32x4){0u, 0u, 0u, 0u};
            if (n > 0 || r >= 128) v = *((const u32x4*)(P + (size_t)(rowbase + r) * PW + C_BK + kvh * 64 + c * 8));
            *(LAS u32x4*)(Kl + r * PK + c * 16) = v; }
        for (int i = tid; i < 2048; i += 512) { const int r = i >> 3, c = i & 7; u32x4 v = (u32x4){0u, 0u, 0u, 0u};
            if (n > 0 || r >= 128) v = *(const u32x4*)(P + (size_t)(rowbase + r) * PW + C_BV + kvh * 64 + c * 8);
            *(LAS u32x4*)(VT + r * PV + c * 16) = v; }
        __syncthreads();
        const bf16_t* qq0 = P + ((size_t)ci * 128 + 16 * ((wid & 1) * 4) + l15) * PW + C_BQ + (kvh * 4 + (wid >> 1)) * 64 + lq * 8;
        bf16x8 qn0 = *(const bf16x8*)qq0, qn1 = *(const bf16x8*)(qq0 + 32);
        for (int it = 0; it < 4; ++it) {
            const bf16x8 q0 = qn0, q1 = qn1;
            if (it < 3) { const bf16_t* qq = qq0 + (size_t)(16 * (it + 1)) * PW; qn0 = *(const bf16x8*)qq; qn1 = *(const bf16x8*)(qq + 32); }
            const int g = wid >> 1, qt = (wid & 1) * 4 + it, h = kvh * 4 + g;
            const float slope = fexp2(-(float)(h + 1)), sink = sinks[h];
            const size_t qrow = (size_t)ci * 128 + 16 * qt + l15;
            bf16_t* qp = P + qrow * PW + C_BQ + h * 64;
            const int kt0 = qt & ~1;
            f32x4 sc[10];
#pragma unroll
            for (int i = 0; i < 10; ++i) { const LAS unsigned char* pa = Kl + (16 * (kt0 + i) + l15) * PK + lq * 16;
                f32x4 a = __builtin_amdgcn_mfma_f32_16x16x32_bf16(*(const LAS bf16x8*)pa, q0, (f32x4){0.f, 0.f, 0.f, 0.f}, 0, 0, 0);
                sc[i] = __builtin_amdgcn_mfma_f32_16x16x32_bf16(*(const LAS bf16x8*)(pa + 64), q1, a, 0, 0, 0); }
            const int qpos = 128 + 16 * qt + l15; float mx = sink;
#pragma unroll
            for (int i = 0; i < 10; ++i)
#pragma unroll
                for (int j = 0; j < 4; ++j) { const int kpos = 16 * (kt0 + i) + 4 * lq + j, dist = qpos - kpos; const bool valid = dist >= 0 && dist < 128 && (n > 0 || kpos >= 128);
                    const float s = valid ? sc[i][j] * 0.125f - slope * (float)dist : -INFINITY; sc[i][j] = s; mx = fmaxf(mx, s); }
            mx = fmaxf(mx, __shfl_xor(mx, 16)); mx = fmaxf(mx, __shfl_xor(mx, 32));
            float sum = 0.f;
#pragma unroll
            for (int i = 0; i < 10; ++i)
#pragma unroll
                for (int j = 0; j < 4; ++j) { const float p = fexp2((sc[i][j] - mx) * LOG2E); sc[i][j] = p; sum += p; }
            sum += __shfl_xor(sum, 16); sum += __shfl_xor(sum, 32);
            sum += fexp2((sink - mx) * LOG2E);
            const float inv = 1.0f / sum;
#pragma unroll
            for (int i = 0; i < 10; ++i) { u32x2 w; w.x = pk2(sc[i][0] * inv, sc[i][1] * inv); w.y = pk2(sc[i][2] * inv, sc[i][3] * inv);
                *(LAS u32x2*)(Pl + l15 * PP + (16 * i + 4 * lq) * 2) = w; }
            asm volatile("s_waitcnt lgkmcnt(0)" ::: "memory");
#pragma unroll
            for (int dt = 0; dt < 4; ++dt) { f32x4 acc = (f32x4){0.f, 0.f, 0.f, 0.f};
#pragma unroll
                for (int s5 = 0; s5 < 5; ++s5) { const bf16x8 a = ld_tr_frag(VT, PV, 16 * kt0 + 32 * s5, 16 * dt, lane);
                    const bf16x8 b = *(const LAS bf16x8*)(Pl + l15 * PP + (32 * s5 + 8 * lq) * 2);
                    acc = __builtin_amdgcn_mfma_f32_16x16x32_bf16(a, b, acc, 0, 0, 0); }
                u32x2 o; o.x = pk2(acc[0], acc[1]); o.y = pk2(acc[2], acc[3]);
                *(u32x2*)(qp + 16 * dt + 4 * lq) = o; }
            asm volatile("s_waitcnt lgkmcnt(0)" ::: "memory");
        }
        __syncthreads();
    }
}

struct KvRegs { u32x4 v[8], k[4]; };
__device__ __forceinline__ void kv_load(KvRegs& R, const bf16_t* P, int u, int tid) {
    const int ci = u >> 2, h = u & 3; const bf16_t* Pr = P + (size_t)ci * 128 * PW;
#pragma unroll
    for (int j = 0; j < 8; ++j) { const int i = tid + 512 * j, r = i >> 5, c = i & 31; R.v[j] = *((const u32x4*)(Pr + (size_t)r * PW + C_CV + h * 256 + c * 8)); }
#pragma unroll
    for (int j = 0; j < 4; ++j) { const int i = tid + 512 * j, r = i >> 4, c = i & 15; R.k[j] = *((const u32x4*)(Pr + (size_t)r * PW + C_CK + h * 128 + c * 8)); }
}
__device__ __forceinline__ void kv_store(LAS unsigned char* L, const KvRegs& R, int u, int tid) {
    constexpr int PVI = 528, PKI = 272; LAS unsigned char* Vi = L; LAS unsigned char* Ki = L + 128 * PVI;
    const float lg = log2f(1.0f - exp2f(-5.0f - (float)(u & 3)));
#pragma unroll
    for (int j = 0; j < 8; ++j) { const int i = tid + 512 * j, r = i >> 5, c = i & 31; *(LAS u32x4*)(Vi + r * PVI + c * 16) = R.v[j]; }
#pragma unroll
    for (int j = 0; j < 4; ++j) { const int i = tid + 512 * j, r = i >> 4, c = i & 15; const float kw = 0.08838834764831845f * fexp2(lg * (float)(127 - r)); const u32x4 v = R.k[j];
        u32x4 o; o.x = pk2(bflo(v.x) * kw, bfhi(v.x) * kw); o.y = pk2(bflo(v.y) * kw, bfhi(v.y) * kw); o.z = pk2(bflo(v.z) * kw, bfhi(v.z) * kw); o.w = pk2(bflo(v.w) * kw, bfhi(v.w) * kw);
        *(LAS u32x4*)(Ki + r * PKI + c * 16) = o; }
}
__device__ __forceinline__ void kv_compute(LAS unsigned char* L, bf16_t* KV, int u, int tid) {
    const int lane = tid & 63, wid = tid >> 6, l15 = lane & 15, lq = lane >> 4;
    constexpr int PVI = 528, PKI = 272; const LAS unsigned char* Vi = L; const LAS unsigned char* Ki = L + 128 * PVI;
    bf16_t* out = KV + (size_t)u * 32768;
    bf16x8 bfr[2][4];
#pragma unroll
    for (int ee = 0; ee < 2; ++ee)
#pragma unroll
        for (int s = 0; s < 4; ++s) bfr[ee][s] = ld_tr_frag(Vi, PVI, 32 * s, 16 * (2 * wid + ee), lane);
#pragma unroll 2
    for (int dt = 0; dt < 8; ++dt) { bf16x8 af[4];
#pragma unroll
        for (int s = 0; s < 4; ++s) af[s] = ld_tr_frag(Ki, PKI, 32 * s, 16 * dt, lane);
#pragma unroll
        for (int ee = 0; ee < 2; ++ee) { f32x4 acc = (f32x4){0.f, 0.f, 0.f, 0.f};
#pragma unroll
            for (int s = 0; s < 4; ++s) acc = __builtin_amdgcn_mfma_f32_16x16x32_bf16(af[s], bfr[ee][s], acc, 0, 0, 0);
            u32x2 o; o.x = pk2(acc[0], acc[1]); o.y = pk2(acc[2], acc[3]);
            *(u32x2*)(out + (16 * (2 * wid + ee) + l15) * 128 + 16 * dt + 4 * lq) = o; } }
}

__device__ __forceinline__ void phase_scan(bf16_t* KV, int gtid, int gthreads) {
    for (int w = gtid; w < 65536 * (MH / 16384); w += gthreads) {
        const int b = w >> 16, h = (w >> 14) & 3, e2 = w & 16383;
        const float decay = exp2f(128.0f * log2f(1.0f - exp2f(-5.0f - (float)h)));
        float st0 = 0.f, st1 = 0.f;
        unsigned* base = (unsigned*)(KV + ((size_t)(b * 128) * 4 + h) * 32768) + e2;
        for (int n0 = 0; n0 < 128; n0 += 16) {
            unsigned v[16];
#pragma unroll
            for (int i = 0; i < 16; ++i) v[i] = *(base + (size_t)(n0 + i) * 4 * 16384);
#pragma unroll
            for (int i = 0; i < 16; ++i) { base[(size_t)(n0 + i) * 4 * 16384] = pk2(st0, st1);
                st0 = decay * st0 + bflo(v[i]); st1 = decay * st1 + bfhi(v[i]); }
        }
    }
}

struct RetRegs { u32x4 q[4], k[4]; };
__device__ __forceinline__ void ret_load(RetRegs& R, const bf16_t* P, int u, int tid) {
    const int ci = u >> 2, h = u & 3;
#pragma unroll
    for (int j = 0; j < 4; ++j) { const int i = tid + 512 * j, r = i >> 4, c = i & 15; const bf16_t* src = P + ((size_t)ci * 128 + r) * PW + h * 128 + c * 8;
        R.q[j] = *((const u32x4*)(src + C_CQ)); R.k[j] = *((const u32x4*)(src + C_CK)); }
}
__device__ __forceinline__ void unit_ret(LAS unsigned char* L, bf16_t* P, const bf16_t* KV, const float* gn, int u, int tid, RetRegs& RR, int u_next) {
    asm volatile("" : "+v"(tid));
    const int lane = tid & 63, wid = tid >> 6, l15 = lane & 15, lq = lane >> 4;
    constexpr int PT = 272, R = 34816;
    LAS unsigned char* Ql = L; LAS unsigned char* Kl = L + R; LAS unsigned char* Pl = L + 2 * R; LAS unsigned char* Sl = L + 3 * R;
    const int ci = u >> 2, h = u & 3; const size_t row0 = (size_t)ci * 128;
    const float lg = log2f(1.0f - exp2f(-5.0f - (float)h));
#pragma unroll
    for (int j = 0; j < 4; ++j) { const int i = tid + 512 * j, r = i >> 4, c = i & 15; *(LAS u32x4*)(Ql + r * PT + c * 16) = RR.q[j]; *(LAS u32x4*)(Kl + r * PT + c * 16) = RR.k[j]; }
    __syncthreads();
    const int t = 16 * wid + l15;
    u32x4 pv[4], ps[4];
#pragma unroll
    for (int j = 0; j < 4; ++j) { const int i = tid + 512 * j, r = i >> 4, c = i & 15;
        pv[j] = *((const u32x4*)(P + (row0 + r) * PW + C_CV + h * 256 + c * 8));
        ps[j] = *((const u32x4*)(KV + (size_t)u * 32768 + r * 128 + c * 8)); }
    {   const LAS unsigned char* pb = Ql + t * PT + lq * 16;
        for (int st = 0; st < 8; ++st) { f32x4 acc = (f32x4){0.f, 0.f, 0.f, 0.f};
            if (st <= wid) { const LAS unsigned char* pa = Kl + (16 * st + l15) * PT + lq * 16; acc = mma_k<4>(pa, pb, acc); }
            float v[4];
#pragma unroll
            for (int j = 0; j < 4; ++j) { const int s = 16 * st + 4 * lq + j; v[j] = (s <= t) ? acc[j] * 0.08838834764831845f * fexp2(lg * (float)(t - s)) : 0.f; }
            u32x2 w; w.x = pk2(v[0], v[1]); w.y = pk2(v[2], v[3]);
            *(LAS u32x2*)(Pl + t * PT + (16 * st + 4 * lq) * 2) = w; }
    }
    __syncthreads();
    f32x4 o[16];
    const float qw = fexp2(lg * (float)(t + 1));
#pragma unroll
    for (int hf = 0; hf < 2; ++hf) {
#pragma unroll
        for (int j = 0; j < 4; ++j) { const int i = tid + 512 * j, r = i >> 4, c = i & 15;
            *(LAS u32x4*)(Kl + r * PT + c * 16) = pv[j]; *(LAS u32x4*)(Sl + r * PT + c * 16) = ps[j]; }
        __syncthreads();
        if (hf == 0) {
#pragma unroll
            for (int j = 0; j < 4; ++j) { const int i = tid + 512 * j, r = i >> 4, c = i & 15;
                pv[j] = *((const u32x4*)(P + (row0 + r) * PW + C_CV + h * 256 + 128 + c * 8));
                ps[j] = *((const u32x4*)(KV + (size_t)u * 32768 + (128 + r) * 128 + c * 8)); } }
        const LAS unsigned char* pbP = Pl + t * PT + lq * 16; const LAS unsigned char* pbQ = Ql + t * PT + lq * 16;
#pragma unroll
        for (int et = 0; et < 8; ++et) { const LAS unsigned char* paS = Sl + (16 * et + l15) * PT + lq * 16;
            f32x4 ai = (f32x4){0.f, 0.f, 0.f, 0.f};
#pragma unroll
            for (int s = 0; s < 4; ++s) ai = __builtin_amdgcn_mfma_f32_16x16x32_bf16(ld_tr_frag(Kl, PT, 32 * s, 16 * et, lane), *(const LAS bf16x8*)(pbP + s * 64), ai, 0, 0, 0);
            const f32x4 ac = mma_k<4>(paS, pbQ, (f32x4){0.f, 0.f, 0.f, 0.f});
            o[hf * 8 + et] = ai + ac * qw; }
        __syncthreads();
    }
    if (u_next >= 0) ret_load(RR, P, u_next, tid);
    float sum = 0.f;
#pragma unroll
    for (int i = 0; i < 16; ++i) sum += (o[i][0] + o[i][1]) + (o[i][2] + o[i][3]);
    sum += __shfl_xor(sum, 16); sum += __shfl_xor(sum, 32);
    const float mean = sum * (1.0f / 256.0f); float var = 0.f;
#pragma unroll
    for (int i = 0; i < 16; ++i) { const f32x4 dd = o[i] - mean; var += (dd[0] * dd[0] + dd[1] * dd[1]) + (dd[2] * dd[2] + dd[3] * dd[3]); }
    var += __shfl_xor(var, 16); var += __shfl_xor(var, 32);
    const float rstd = rsqrtf(var * (1.0f / 256.0f) + GN_EPS);
#pragma unroll
    for (int i = 0; i < 16; ++i) { const int e = 16 * i + 4 * lq; bf16_t* gp = P + (row0 + t) * PW + C_CG + h * 256 + e; const u32x2 gv = *((const u32x2*)gp); const f32x4 gg = *(const f32x4*)(gn + h * 256 + e);
        u32x2 w; w.x = pk2((o[i][0] - mean) * rstd * gg[0] * bflo(gv.x), (o[i][1] - mean) * rstd * gg[1] * bfhi(gv.x));
        w.y = pk2((o[i][2] - mean) * rstd * gg[2] * bflo(gv.y), (o[i][3] - mean) * rstd * gg[3] * bfhi(gv.y));
        *(u32x2*)gp = w; if ((i & 7) == 7) asm volatile("" ::: "memory"); }
    __syncthreads();
}

__device__ __forceinline__ void transpose_item(const float* W, int K, int N, bf16_t* WT, const float* gk, bool swiglu, LAS float* scr, int item, int lane) {
    const int nblk = N / 64, kb = item / nblk, nb = item % nblk, k0 = 64 * kb, n0 = 64 * nb;
    const int kr = lane >> 4, nq = 4 * (lane & 15);
    f32x4 v[16];
#pragma unroll
    for (int i = 0; i < 16; ++i) v[i] = __builtin_nontemporal_load((const f32x4*)(W + (size_t)(k0 + 4 * i + kr) * N + n0 + nq));
#pragma unroll
    for (int i = 0; i < 16; ++i) { const int kk = 4 * i + kr; const float g = gk ? gk[k0 + kk] : 1.0f; LAS float* d = scr + kk * 65 + nq;
        d[0] = v[i][0] * g; d[1] = v[i][1] * g; d[2] = v[i][2] * g; d[3] = v[i][3] * g; }
    asm volatile("s_waitcnt lgkmcnt(0)" ::: "memory");
    int d0 = n0; if (swiglu) { const int bj = n0 / F, rem = n0 % F; d0 = 256 * (rem / 128) + 128 * bj + (rem % 128); }
    const int c = lane & 7;
#pragma unroll
    for (int j = 0; j < 8; ++j) { const int n = (lane >> 3) + 8 * j; const LAS float* s = scr + (8 * c) * 65 + n;
        u32x4 o; o.x = pk2(s[0 * 65], s[1 * 65]); o.y = pk2(s[2 * 65], s[3 * 65]); o.z = pk2(s[4 * 65], s[5 * 65]); o.w = pk2(s[6 * 65], s[7 * 65]);
        *(u32x4*)(WT + (size_t)(d0 + n) * K + k0 + 8 * c) = o; }
    asm volatile("s_waitcnt lgkmcnt(0)" ::: "memory");
}

#define XB_TMO      128
#define XB_XCNT(j)  (256  + 64 * (j))
#define XB_XSUB(j)  (1280 + 64 * (j))
#define XB_XGEN(j)  (2304 + 64 * (j))
#define XB_TOP      3328
#define XB_TOPGEN   3392
#define XCD_BAR_WORDS 3456
#define XB_SPIN_CAP (1u << 18)
__device__ __forceinline__ unsigned xb_ld(unsigned* p)              { return __hip_atomic_load(p, __ATOMIC_RELAXED, __HIP_MEMORY_SCOPE_AGENT); }
__device__ __forceinline__ unsigned xb_add(unsigned* p, unsigned v) { return __hip_atomic_fetch_add(p, v, __ATOMIC_RELAXED, __HIP_MEMORY_SCOPE_AGENT); }
__device__ __forceinline__ unsigned xb_xcc_id() { return (unsigned)__builtin_amdgcn_s_getreg((3 << 11) | 20) & 0xFu; }
#define XB_SPIN(cond, bar) do { unsigned _sp = 0; while (cond) { __builtin_amdgcn_s_sleep(1); \
    if ((++_sp & 255u) == 0u) { if (xb_ld(&(bar)[XB_TMO])) break; if (_sp > XB_SPIN_CAP) { atomicAdd(&(bar)[XB_TMO], 1u); break; } } } } while (0)
struct XcdBarrier { unsigned* bar; unsigned x; volatile LAS unsigned* st; };
__device__ __forceinline__ XcdBarrier xcd_barrier_post(unsigned* bar, volatile LAS unsigned* st) {
    XcdBarrier b; b.bar = bar; b.x = xb_xcc_id(); b.st = st;
    if (threadIdx.x == 0) (void)xb_add(&bar[XB_XCNT(b.x)], 1u);
    return b;
}
__device__ __forceinline__ void xcd_barrier_complete(unsigned* bar, unsigned x, unsigned& nloc, unsigned& nx) {
    const unsigned G = gridDim.x * gridDim.y * gridDim.z;
    unsigned sum, cnt, mine, sp = 0u;
    for (;;) {
        sum = 0u; cnt = 0u; mine = 0u;
#pragma unroll
        for (unsigned j = 0; j < 16; ++j) { const unsigned c = xb_ld(&bar[XB_XCNT(j)]); sum += c; cnt += (c > 0u) ? 1u : 0u; mine = (j == x) ? c : mine; }
        if (sum == G) break;
        __builtin_amdgcn_s_sleep(1);
        if ((++sp & 255u) == 0u) { if (xb_ld(&bar[XB_TMO])) break; if (sp > XB_SPIN_CAP) { atomicAdd(&bar[XB_TMO], 1u); break; } }
    }
    nloc = mine > 0u ? mine : 1u; nx = cnt > 0u ? cnt : 1u;
}
__device__ __forceinline__ void xcd_barrier(const XcdBarrier& b) {
    asm volatile("s_waitcnt vmcnt(0)" ::: "memory");
    __syncthreads();
    if (threadIdx.x == 0) {
        unsigned* bar = b.bar;
        __builtin_amdgcn_s_waitcnt(0);
        unsigned nloc = b.st[0], nx = b.st[1];
        if (nloc == 0u) { xcd_barrier_complete(bar, b.x, nloc, nx); b.st[0] = nloc; b.st[1] = nx; }
        const unsigned old = xb_add(&bar[XB_XSUB(b.x)], 1u);
        const unsigned gen = old / nloc;
        if (old + 1u == (gen + 1u) * nloc) {
            __builtin_amdgcn_fence(__ATOMIC_RELEASE, "agent");
            asm volatile("s_waitcnt vmcnt(0)" ::: "memory");
            const unsigned og = xb_add(&bar[XB_TOP], 1u);
            const unsigned tg = og / nx;
            if (og + 1u == (tg + 1u) * nx) xb_add(&bar[XB_TOPGEN], 1u);
            else XB_SPIN(xb_ld(&bar[XB_TOPGEN]) == tg, bar);
            __builtin_amdgcn_fence(__ATOMIC_ACQUIRE, "agent");
            xb_add(&bar[XB_XGEN(b.x)], 1u);
            asm volatile("s_waitcnt vmcnt(0)" ::: "memory");
        } else {
            XB_SPIN(xb_ld(&bar[XB_XGEN(b.x)]) == gen, bar);
            __builtin_amdgcn_fence(__ATOMIC_ACQUIRE, "agent");
            asm volatile("s_waitcnt vmcnt(0)" ::: "memory");
        }
    }
    __syncthreads();
}

struct Args { const float* in[20]; float* out; unsigned char* ws; int ph_lo, ph_hi; };

constexpr int LDS_BYTES = 147456;

__global__ void __launch_bounds__(512, 2) mk_fwd(Args a) {
    extern __shared__ __attribute__((aligned(16))) unsigned char lds_raw[];
    LAS unsigned char* L = (LAS unsigned char*)lds_raw;
    volatile LAS unsigned* xst = (volatile LAS unsigned*)(L + 131072 + 8192);
    if (threadIdx.x == 0) { xst[0] = 0u; xst[1] = 0u; }
    __syncthreads();
    const XcdBarrier xbar = xcd_barrier_post((unsigned*)(a.ws + WS_BAR), xst);
#ifndef MK_STOP
#define MK_STOP NPHASES
#endif
    for (int pidx = a.ph_lo; pidx < a.ph_hi; ++pidx) {
        const int ph = (MK_REPBLK) ? ((pidx > 6) ? pidx - 4 : pidx) : (MK_REPPH >= 0) ? ((pidx > MK_REPPH) ? pidx - 1 : pidx) : ((!MK_MULTI && MK_STOP < NPHASES && pidx == a.ph_hi - 1) ? NPHASES - 1 : pidx);
        int tid = threadIdx.x; asm volatile("" : "+v"(tid));
        int bid = blockIdx.x; asm volatile("" : "+s"(bid));
        unsigned char* ws = a.ws; asm volatile("" : "+s"(ws));
        const int lane = tid & 63, wave = __builtin_amdgcn_readfirstlane(tid >> 6);
        const int G = gridDim.x;
        float* SS = (float*)(ws + WS_SSP);
        bf16_t* WB = (bf16_t*)(ws + WS_WB);
        bf16_t* XB = (bf16_t*)(ws + WS_XB);
        bf16_t* KV = (bf16_t*)(ws + WS_KV);
        bf16_t* P = (bf16_t*)(ws + WS_P);
        bf16_t* H = P;
        float* OUT = a.out;
        const int l = ph / NPH_LAYER, k0 = (ph == NPHASES - 1) ? 99 : ph % NPH_LAYER;
        const bool inmix = (k0 >= 3 && k0 < 3 + 6 * NB);
        const int bsel = inmix ? (k0 - 3) / 6 : 0;
        const int k = inmix ? 3 + (k0 - 3) % 6 : (k0 == 3 + 6 * NB ? 15 : (k0 == 4 + 6 * NB ? 16 : k0));
        const size_t rowoff = (size_t)bsel * MH;
#if MK_GOVL || MK_NB == 1
        bf16_t* Gt = P + C_GT; bf16_t* Mg = P + C_MG; const int ldg = PW;
#else
        bf16_t* Gt = (bf16_t*)(ws + WS_G) + rowoff * D; bf16_t* Mg = (bf16_t*)(ws + WS_MG) + rowoff * D; const int ldg = D;
#endif
        if (k == 0) {
            int lane_o = lane; asm volatile("" : "+v"(lane_o));
            LAS float* scr = (LAS float*)(L + wave * 16640);
            const int gw = bid * 8 + wave, NGW = G * 8;
            for (int it = gw; it < 6976; it += NGW) {
                int r = it; const float* W; const float* gk = nullptr; bf16_t* WT; int K_, N_; bool sw = false;
                if (r < 1408) { W = a.in[2] + (size_t)l * D * 2 * F; K_ = D; N_ = 2 * F; WT = WB + O_W1IN; gk = a.in[1] + l * D; sw = true; }
                else if ((r -= 1408) < 704) { W = a.in[3] + (size_t)l * F * D; K_ = F; N_ = D; WT = WB + O_W1OUT; }
                else if ((r -= 704) < 1984) { W = a.in[5] + (size_t)l * D * 7936; K_ = D; N_ = 7936; WT = WB + O_WIN; gk = a.in[4] + l * D; }
                else if ((r -= 1984) < 128) { W = a.in[12] + (size_t)l * 512 * D; K_ = 512; N_ = D; WT = WB + O_WBA; }
                else if ((r -= 128) < 128) { W = a.in[13] + (size_t)l * 512 * D; K_ = 512; N_ = D; WT = WB + O_WBB; }
                else if ((r -= 128) < 256) { W = a.in[14] + (size_t)l * D * D; K_ = D; N_ = D; WT = WB + O_WBC; }
                else if ((r -= 256) < 256) { W = a.in[15] + (size_t)l * D * D; K_ = D; N_ = D; WT = WB + O_WOUT; }
                else if ((r -= 256) < 1408) { W = a.in[17] + (size_t)l * D * 2 * F; K_ = D; N_ = 2 * F; WT = WB + O_W2IN; gk = a.in[16] + l * D; sw = true; }
                else { r -= 1408; W = a.in[18] + (size_t)l * F * D; K_ = F; N_ = D; WT = WB + O_W2OUT; }
                transpose_item(W, K_, N_, WT, gk, sw, scr, r, lane_o);
            }
            {
                const float* wsrc = a.in[8] + (size_t)l * 65536;
                for (int i = bid * 512 + tid; i < 65536; i += G * 512) { const int tt = (i >> 7) & 127, s = i & 127; WB[O_WS + i] = (bf16_t)f2bf(s <= tt ? wsrc[i] : 0.f); }
            }
            if (l == 0) {
                const float* x = a.in[0];
                for (int m = gw; m < M; m += NGW) { const f32x4* xr = (const f32x4*)(x + (size_t)m * D) + lane; float s = 0.f; u32x2* o8 = (u32x2*)(XB + (size_t)m * D) + lane;
#pragma unroll
                    for (int j = 0; j < 4; ++j) { const f32x4 v = __builtin_nontemporal_load(xr + 64 * j); s += (v[0] * v[0] + v[1] * v[1]) + (v[2] * v[2] + v[3] * v[3]); u32x2 w; w.x = pk2(v[0], v[1]); w.y = pk2(v[2], v[3]); o8[64 * j] = w; }
#pragma unroll
                    for (int o = 1; o < 64; o <<= 1) s += __shfl_xor(s, o);
                    if (lane == 0) *(f32x4*)(SS + (size_t)m * 4) = (f32x4){s, 0.f, 0.f, 0.f}; }
            }
            __syncthreads();
        } else if (k == 1 || k == 15) {
            pg8::Gemm g{XB, WB + (k == 1 ? O_W1IN : O_W2IN), M, 2 * F, D, D}; pg8::StaticOrder S; S.init(M, 2 * F, G, bid);
            pg8::EpiSwiglu E{H, SS + (size_t)(3 * l + (k == 1 ? 0 : 2)) * M * 4};
            pg8::gemm_phase<pg8::EpiSwiglu>(L, g, S, E);
        } else if (k == 2 || k == 16) {
            pg8::Gemm g{H, WB + (k == 2 ? O_W1OUT : O_W2OUT), M, D, F, F}; pg8::StaticOrder S; S.init(M, D, G, bid);
            const int sidx = 3 * l + (k == 2 ? 1 : 3);
            pg8::EpiResid E{(l == 0 && k == 2) ? a.in[0] : nullptr, XB, SS + (size_t)sidx * M * 4, 0.5f, (LAS float*)(L + 131072)};
            pg8::gemm_phase<pg8::EpiResid>(L, g, S, E);
        } else if (k == 8) {
            pg8::Gemm g{Mg, WB + O_WOUT, MH, D, D, ldg}; pg8::StaticOrder S; S.init(MH, D, G, bid);
            pg8::EpiResid E{nullptr, XB + rowoff * D, SS + (size_t)(3 * l + 2) * M * 4 + rowoff * 4, 1.0f, (LAS float*)(L + 131072)};
            pg8::gemm_phase<pg8::EpiResid>(L, g, S, E);
        } else if (k == 3) {
            pg8::Gemm g{XB + rowoff * D, WB + O_WIN, MH, PW, D, D}; pg8::StaticOrder S; S.init(MH, PW, G, bid);
            pg8::EpiInproj E{P, SS + (size_t)(3 * l + 1) * M * 4 + rowoff * 4};
            pg8::gemm_phase<pg8::EpiInproj>(L, g, S, E);
        } else if (k == 4) {
            int i = bid;
            for (; i < 2 * NCH; i += G) {
                if (i < NCH) unit_attn(L, P, a.in[10] + l * 8, i, tid);
                else unit_gmlp(L, P, WB + O_WS, a.in[7] + l * 512, a.in[9] + l * 512, i - NCH, tid);
            }
            if (i < 6 * NCH) {
                int tk = tid; asm volatile("" : "+v"(tk));
                KvRegs R; kv_load(R, P, i - 2 * NCH, tk);
                for (; i < 6 * NCH; i += G) { const int u = i - 2 * NCH;
                    kv_store(L, R, u, tk); __syncthreads();
                    if (i + G < 6 * NCH) kv_load(R, P, i + G - 2 * NCH, tk);
                    kv_compute(L, KV, u, tk); __syncthreads(); }
            }
        } else if (k == 5) {
            phase_scan(KV, bid * 512 + tid, G * 512);
        } else if (k == 6) {
            if (bid < 4 * NCH) { int tk = tid; asm volatile("" : "+v"(tk)); RetRegs R; ret_load(R, P, bid, tk);
                for (int i = bid; i < 4 * NCH; i += G) unit_ret(L, P, KV, a.in[11] + l * 1024, i, tid, R, (i + G < 4 * NCH) ? i + G : -1); }
        } else if (k == 7) {
            for (int br = 0; br < 3; ++br) {
                const int gi = (br == 0) ? 2 : (br - 1);
                if (2 * br >= MK_P7) break;
                {   pg8::Gemm g{XB + rowoff * D, WB + O_WIN + (size_t)(PW + gi * D) * D, MH, D, D, D}; pg8::StaticOrder S; S.init(MH, D, G, bid);
                    pg8::EpiGate E{Gt, SS + (size_t)(3 * l + 1) * M * 4 + rowoff * 4, a.in[6] + l * 3 * D + gi * D, ldg, (MK_X2) ? OUT + rowoff * D : nullptr};
                    pg8::gemm_phase<pg8::EpiGate>(L, g, S, E);
#if MK_T10
                    {
                        asm volatile("s_waitcnt vmcnt(0)" ::: "memory"); __syncthreads();
                        pg8::Unit uu; for (int ui = 0; S.next(ui, uu); ++ui)
                            for (int e = tid; e < 256 * 256; e += 512) { const int r = e >> 8, c = e & 255; const size_t row = (size_t)uu.pm * 256 + r, col = (size_t)uu.pn * 256 + c;
                                OUT[(rowoff + row) * D + col] = bflo((unsigned)Gt[row * ldg + col]); }
                    }
#endif
                }
                if (2 * br + 1 >= MK_P7) break;
                {   pg8::Gemm g; pg8::StaticOrder S; S.init(MH, D, G, bid);
                    if (br == 0) g = pg8::Gemm{P + C_CG, WB + O_WBC, MH, D, D, PW}; else if (br == 1) g = pg8::Gemm{P + C_AU, WB + O_WBA, MH, D, 512, PW}; else g = pg8::Gemm{P + C_BQ, WB + O_WBB, MH, D, 512, PW};
                    pg8::EpiMerge E{Gt, Mg, br == 0 ? 1 : 0, ldg};
                    pg8::gemm_phase<pg8::EpiMerge>(L, g, S, E); }
            }
        } else {
#if MK_X2 || MK_T10
            continue;
#endif
#ifdef MK_DBG
#if MK_DELAY
            { const unsigned long long t0 = __builtin_amdgcn_s_memrealtime(); while (__builtin_amdgcn_s_memrealtime() - t0 < 30000ull) __builtin_amdgcn_s_sleep(32); }
            __builtin_amdgcn_fence(__ATOMIC_ACQUIRE, "agent"); asm volatile("s_waitcnt vmcnt(0)" ::: "memory"); __syncthreads();
#endif
            {   const bf16_t* src16 = (MK_DBG == 1) ? Gt : Mg;
                for (size_t i = (size_t)bid * 512 + tid; i < (size_t)M * D; i += (size_t)G * 512) { const size_t m = i >> 10, c = i & 1023; OUT[i] = (m < (size_t)MH) ? bflo((unsigned)src16[m * ldg + c]) : 0.f; } }
            continue;
#endif
            const int gw = bid * 8 + wave, NGW = G * 8; const float* fg = a.in[19]; const float* ss = SS + (size_t)6 * M * 4;
            for (int m = gw; m < M; m += NGW) { f32x4* xr = (f32x4*)(OUT + (size_t)m * D) + lane; const u32x2* xs = (const u32x2*)(XB + (size_t)m * D) + lane; const float r = row_rstd(ss, m);
#pragma unroll
                for (int j = 0; j < 4; ++j) { const u32x2 bw = xs[64 * j]; const f32x4 v = (f32x4){bflo(bw.x), bfhi(bw.x), bflo(bw.y), bfhi(bw.y)}; const f32x4 gq = *((const f32x4*)fg + lane + 64 * j); __builtin_nontemporal_store(v * r * gq, xr + 64 * j); } }
        }
        if (pidx + 1 < a.ph_hi) {
            xcd_barrier(xbar);
            if (pidx == a.ph_lo) { asm volatile("s_waitcnt vmcnt(0) lgkmcnt(0)" ::: "memory"); __syncthreads(); cg::this_grid().sync();
                __builtin_amdgcn_fence(__ATOMIC_ACQUIRE, "agent"); asm volatile("s_waitcnt vmcnt(0)" ::: "memory"); __syncthreads(); }
        }
    }
}

extern "C" void kernel_launch(void* const* d_in, const int* in_sizes, int n_in, void* d_out, int out_size, void* d_ws, size_t ws_size, hipStream_t stream) {
    static int grid = 0;
    if (grid == 0) {
        if (n_in != 20 || in_sizes[0] != M * D || out_size != M * D || ws_size < WS_END) { fprintf(stderr, "kernel_launch: unexpected shapes / workspace (n_in %d, ws %zu, need %zu)\n", n_in, ws_size, (size_t)WS_END); grid = -1; return; }
        int dev = 0, cus = 0, per_cu = 0;
        hipGetDevice(&dev); hipDeviceGetAttribute(&cus, hipDeviceAttributeMultiprocessorCount, dev);
        if (hipFuncSetAttribute((const void*)mk_fwd, hipFuncAttributeMaxDynamicSharedMemorySize, LDS_BYTES) != hipSuccess) { fprintf(stderr, "kernel_launch: hipFuncSetAttribute failed\n"); grid = -1; return; }
        if (hipOccupancyMaxActiveBlocksPerMultiprocessor(&per_cu, (const void*)mk_fwd, 512, LDS_BYTES) != hipSuccess || per_cu < 1) { fprintf(stderr, "kernel_launch: occupancy query says %d\n", per_cu); per_cu = 1; }
        (void)hipGetLastError();
        grid = cus * 1;
    }
    if (grid < 0) return;
    (void)hipMemsetAsync((char*)d_ws + WS_BAR, 0, 16384, stream);
    Args a{};
    for (int i = 0; i < 20; ++i) a.in[i] = (const float*)d_in[i];
    a.out = (float*)d_out; a.ws = (unsigned char*)d_ws;
#if MK_MULTI
    for (int i = 0; i < ((MK_STOP < NPHASES) ? MK_STOP + 1 : NPHASES); ++i) { const int ph = (MK_STOP < NPHASES && i == MK_STOP) ? NPHASES - 1 : i; a.ph_lo = ph; a.ph_hi = ph + 1; hipLaunchKernelGGL(mk_fwd, dim3(grid), dim3(512), LDS_BYTES, stream, a); }
#else
    a.ph_lo = 0; a.ph_hi = (MK_REPBLK) ? NPHASES + 4 : (MK_REPPH >= 0) ? NPHASES + 1 : ((MK_STOP < NPHASES) ? MK_STOP + 1 : NPHASES);
    void* args[] = {&a};
    hipError_t e = hipLaunchCooperativeKernel((const void*)mk_fwd, dim3(grid), dim3(512), args, LDS_BYTES, stream);
    if (e != hipSuccess) fprintf(stderr, "cooperative launch failed: %s (grid %d)\n", hipGetErrorString(e), grid);
#endif
}
```
